# Optimizing an MI355X kernel written in HIP

```python
import jax, jax.numpy as jnp
from jax import lax
import numpy as np

D_MODEL = 2048
BATCH = 4
SEQ = 4096
DEPTH = 2

D_MIX = D_MODEL
HEAD_DIM = 64
D_ATTN = D_MIX // 2
N_HEADS = D_ATTN // HEAD_DIM
N_KV_HEADS = N_HEADS // 8
WINDOW = 128
BLOCK = WINDOW
D_CONV = D_MIX // 4
CONV_WIDTH = 3
D_LRU = D_MIX // 4
LRU_HEAD_DIM = 64
LRU_HEADS = D_LRU // LRU_HEAD_DIM
LRU_CONV_WIDTH = 4
LRU_C = 8.0
D_KV = N_KV_HEADS * HEAD_DIM
D_IN = D_ATTN + 2 * D_KV + 3 * D_CONV + 2 * D_LRU
D_FF = 5632
N_EXPERTS = 8
TOP_K = 2
D_EXPERT = D_FF // 2
N_DENSE = (DEPTH + 1) // 2
N_MOE = DEPTH // 2
EPS = 1e-6

kernel_name = "hymba_style_hybrid_swa_conv_rglru_moe"


def rmsnorm(x, g):
    xf = x.astype(jnp.float32)
    y = xf * lax.rsqrt(jnp.mean(xf * xf, axis=-1, keepdims=True) + EPS)
    return y.astype(x.dtype) * g


def causal_depthwise_conv(u, w):
    width = w.shape[0]
    s = u.shape[1]
    up = jnp.pad(u, ((0, 0), (width - 1, 0), (0, 0)))
    y = w[0] * u
    for k in range(1, width):
        y = y + w[k] * up[:, width - 1 - k: width - 1 - k + s]
    return y


def sliding_window_attention(q, k, v, sinks):
    b, s, _ = q.shape
    nb = s // BLOCK
    g = N_HEADS // N_KV_HEADS
    f32 = jnp.float32
    qb = q.astype(f32).reshape(b, nb, BLOCK, N_KV_HEADS, g, HEAD_DIM)
    kb = k.astype(f32).reshape(b, nb, BLOCK, N_KV_HEADS, HEAD_DIM)
    vb = v.astype(f32).reshape(b, nb, BLOCK, N_KV_HEADS, HEAD_DIM)
    pad = ((0, 0), (1, 0), (0, 0), (0, 0), (0, 0))
    kw = jnp.concatenate([jnp.pad(kb[:, :-1], pad), kb], axis=2)
    vw = jnp.concatenate([jnp.pad(vb[:, :-1], pad), vb], axis=2)
    scores = jnp.einsum("bnqkgd,bnskd->bnkgqs", qb, kw) * (HEAD_DIM ** -0.5)
    q_idx = jnp.arange(BLOCK)[:, None] + BLOCK
    k_idx = jnp.arange(2 * BLOCK)[None, :]
    dist = q_idx - k_idx
    in_band = (dist >= 0) & (dist < WINDOW)
    has_keys = (jnp.arange(nb) > 0)[:, None, None] | (k_idx >= BLOCK)[None]
    valid = in_band[None] & has_keys
    scores = jnp.where(valid[None, :, None, None], scores, -jnp.inf)
    sink = sinks.astype(f32).reshape(1, 1, N_KV_HEADS, g, 1, 1)
    m = jnp.maximum(scores.max(axis=-1, keepdims=True), sink)
    p = jnp.exp(scores - m)
    denom = p.sum(axis=-1, keepdims=True) + jnp.exp(sink - m)
    out = jnp.einsum("bnkgqs,bnskd->bnqkgd", p / denom, vw)
    return out.reshape(b, s, D_ATTN).astype(q.dtype)


def _linear_recurrence_combine(left, right):
    a_l, b_l = left
    a_r, b_r = right
    return a_l * a_r, a_r * b_l + b_r


def rg_lru_branch(lx, lg, conv_w, conv_b, wa, ba, wx, bx, lam):
    b, s, _ = lx.shape
    xc = causal_depthwise_conv(lx, conv_w) + conv_b
    xh = xc.reshape(b, s, LRU_HEADS, LRU_HEAD_DIM)
    r = jax.nn.sigmoid(jnp.einsum("bshi,hij->bshj", xh, wa).reshape(b, s, D_LRU) + ba)
    i = jax.nn.sigmoid(jnp.einsum("bshi,hij->bshj", xh, wx).reshape(b, s, D_LRU) + bx)
    f32 = jnp.float32
    log_a = -LRU_C * r.astype(f32) * jax.nn.softplus(-lam.astype(f32))
    a = jnp.exp(log_a)
    u = jnp.sqrt(-jnp.expm1(2.0 * log_a)) * (i * xc).astype(f32)
    _, h = lax.associative_scan(_linear_recurrence_combine, (a, u), axis=1)
    return h.astype(lx.dtype) * jax.nn.gelu(lg)


def hybrid_mixer(h, w_in, sinks, conv_w, lru_conv_w, lru_conv_b, lru_wa, lru_ba,
                 lru_wx, lru_bx, lru_lambda, mix_norm, w_out):
    sizes = (D_ATTN, D_KV, D_KV, D_CONV, D_CONV, D_CONV, D_LRU, D_LRU)
    offsets = [int(o) for o in np.cumsum(sizes)[:-1]]
    proj = h @ w_in
    q, k, v, cb, cc, cx, lx, lg = jnp.split(proj, offsets, axis=-1)
    y_attn = sliding_window_attention(q, k, v, sinks)
    y_conv = cb * causal_depthwise_conv(cc * cx, conv_w)
    y_lru = rg_lru_branch(lx, lg, lru_conv_w, lru_conv_b, lru_wa, lru_ba,
                          lru_wx, lru_bx, lru_lambda)
    g_attn, g_conv, g_lru = jnp.split(mix_norm, [D_ATTN, D_ATTN + D_CONV])
    y = jnp.concatenate([rmsnorm(y_attn, g_attn), rmsnorm(y_conv, g_conv),
                         rmsnorm(y_lru, g_lru)], axis=-1)
    return y @ w_out


def swiglu(t, wg, wu, wd):
    return (jax.nn.silu(t @ wg) * (t @ wu)) @ wd


def moe_swiglu(h, router_w, wg, wu, wd):
    b, s, d = h.shape
    t = h.reshape(b * s, d)
    logits = (t @ router_w).astype(jnp.float32)
    top_logits, top_idx = lax.top_k(logits, TOP_K)
    top_w = jax.nn.softmax(top_logits, axis=-1)
    gates = jnp.einsum("tk,tke->te", top_w,
                       jax.nn.one_hot(top_idx, N_EXPERTS, dtype=jnp.float32)).astype(h.dtype)
    out = jnp.zeros_like(t)
    for e in range(N_EXPERTS):
        out = out + gates[:, e:e + 1] * swiglu(t, wg[e], wu[e], wd[e])
    return out.reshape(b, s, d)


def setup_inputs(seed: int = 0) -> dict:
    key = jax.random.key(seed)
    ks = jax.random.split(key, 24)
    f32 = jnp.float32

    def normal(k, shape, fan_in):
        return jax.random.normal(k, shape, f32) * (fan_in ** -0.5)

    def gain(k, shape):
        return 1.0 + 0.05 * jax.random.normal(k, shape, f32)

    a0 = jax.random.uniform(ks[11], (DEPTH, D_LRU), f32, minval=0.9, maxval=0.999)
    return {
        "x": jax.random.normal(ks[0], (BATCH, SEQ, D_MODEL), f32),
        "attn_norm": gain(ks[1], (DEPTH, D_MODEL)),
        "w_in": normal(ks[2], (DEPTH, D_MODEL, D_IN), D_MODEL),
        "attn_sinks": 0.5 * jax.random.normal(ks[3], (DEPTH, N_HEADS), f32),
        "conv_w": normal(ks[4], (DEPTH, CONV_WIDTH, D_CONV), CONV_WIDTH),
        "lru_conv_w": normal(ks[5], (DEPTH, LRU_CONV_WIDTH, D_LRU), LRU_CONV_WIDTH),
        "lru_conv_b": 0.01 * jax.random.normal(ks[6], (DEPTH, D_LRU), f32),
        "lru_wa": normal(ks[7], (DEPTH, LRU_HEADS, LRU_HEAD_DIM, LRU_HEAD_DIM), LRU_HEAD_DIM),
        "lru_ba": 0.1 * jax.random.normal(ks[8], (DEPTH, D_LRU), f32),
        "lru_wx": normal(ks[9], (DEPTH, LRU_HEADS, LRU_HEAD_DIM, LRU_HEAD_DIM), LRU_HEAD_DIM),
        "lru_bx": 0.1 * jax.random.normal(ks[10], (DEPTH, D_LRU), f32),
        "lru_lambda": jnp.log(a0) - jnp.log1p(-a0),
        "mix_norm": gain(ks[12], (DEPTH, D_MIX)),
        "w_out": normal(ks[13], (DEPTH, D_MIX, D_MODEL), D_MIX),
        "ffn_norm": gain(ks[14], (DEPTH, D_MODEL)),
        "dense_w_gate": normal(ks[15], (N_DENSE, D_MODEL, D_FF), D_MODEL),
        "dense_w_up": normal(ks[16], (N_DENSE, D_MODEL, D_FF), D_MODEL),
        "dense_w_down": normal(ks[17], (N_DENSE, D_FF, D_MODEL), D_FF),
        "router_w": normal(ks[18], (N_MOE, D_MODEL, N_EXPERTS), D_MODEL),
        "expert_w_gate": normal(ks[19], (N_MOE, N_EXPERTS, D_MODEL, D_EXPERT), D_MODEL),
        "expert_w_up": normal(ks[20], (N_MOE, N_EXPERTS, D_MODEL, D_EXPERT), D_MODEL),
        "expert_w_down": normal(ks[21], (N_MOE, N_EXPERTS, D_EXPERT, D_MODEL), D_EXPERT),
        "final_norm": gain(ks[22], (D_MODEL,)),
    }


def reference(x, attn_norm, w_in, attn_sinks, conv_w, lru_conv_w, lru_conv_b, lru_wa,
              lru_ba, lru_wx, lru_bx, lru_lambda, mix_norm, w_out, ffn_norm,
              dense_w_gate, dense_w_up, dense_w_down, router_w, expert_w_gate,
              expert_w_up, expert_w_down, final_norm):
    for layer in range(DEPTH):
        h = rmsnorm(x, attn_norm[layer])
        x = x + hybrid_mixer(h, w_in[layer], attn_sinks[layer], conv_w[layer],
                             lru_conv_w[layer], lru_conv_b[layer], lru_wa[layer],
                             lru_ba[layer], lru_wx[layer], lru_bx[layer],
                             lru_lambda[layer], mix_norm[layer], w_out[layer])
        h = rmsnorm(x, ffn_norm[layer])
        j = layer // 2
        if layer % 2 == 0:
            x = x + swiglu(h, dense_w_gate[j], dense_w_up[j], dense_w_down[j])
        else:
            x = x + moe_swiglu(h, router_w[j], expert_w_gate[j], expert_w_up[j],
                               expert_w_down[j])
    return rmsnorm(x, final_norm)
```

```cpp
#include <hip/hip_runtime.h>
#include <cstdio>
#include <cstdint>
#ifndef MK_PER_PHASE
#define MK_PER_PHASE 0
#endif
namespace pg8 {
#define PG8_LAS __attribute__((address_space(3)))
typedef unsigned short bf16_t;
typedef short bf16x8 __attribute__((ext_vector_type(8)));
typedef float f32x4 __attribute__((ext_vector_type(4)));
typedef unsigned u32x4 __attribute__((ext_vector_type(4)));
typedef int i32x4 __attribute__((ext_vector_type(4)));
constexpr int BM = 256, BK = 64, HALF = 128, HTB = HALF * BK * 2  , STAGE_BYTES = 8 * HTB, NXCD = 8, WGM = 6, WGM_N8 = 3;

__host__ __device__ __forceinline__ int lds_byte(int r, int c) { const int st = (r >> 4) * 2 + (c >> 5), rr = r & 15, cc = c & 31, ob = rr * 64 + cc * 2; return st * 1024 + (ob ^ (((ob >> 9) & 1) << 5)); }
__host__ __device__ __forceinline__ void stage_rc(int b, int& R, int& C) { const int st = b / 1024, sb = b % 1024, swz = sb ^ (((sb >> 9) & 1) << 5); R = (st >> 1) * 16 + swz / 64; C = (st & 1) * 32 + (swz % 64) / 2; }
__host__ __device__ __forceinline__ int perm32(int rho) { const int n = rho >> 4, i = rho & 15; return 8 * (i >> 2) + 4 * n + (i & 3); }

struct Unit { int pm, pn, eid; size_t bofs; };
struct Gemm { const bf16_t* A; const bf16_t* Bt; int M, N, K; };

struct GroupOrder {
    int nM, nN, nwg, G, c, wgm; int pstart[9]; size_t estride;
    __device__ void init(int nM_, int N, int G_, int c_) { nM = nM_; nN = N / BM; nwg = nM * nN; G = G_; c = c_; estride = 0; wgm = (nN == 8) ? WGM_N8 : WGM;
#pragma unroll
        for (int e = 0; e < 9; ++e) pstart[e] = (e == 0) ? 0 : nM_; }
    __device__ bool next(int i, Unit& u) const {
        const long L = (long)i * G + c; if (L >= nwg) return false;
        int wgid = (int)L; { const int q = nwg / NXCD, r = nwg % NXCD, xcd = wgid % NXCD, off = wgid / NXCD; wgid = (xcd < r ? xcd * (q + 1) : r * (q + 1) + (xcd - r) * q) + off; }
        const int nig = wgm * nN, gid = wgid / nig, fm = gid * wgm, gsz = (nM - fm) < wgm ? (nM - fm) : wgm;
        u.pm = fm + ((wgid % nig) % gsz); u.pn = (wgid % nig) / gsz;
        int e = 0;
#pragma unroll
        for (int k = 1; k < 8; ++k) e += (u.pm >= pstart[k]) ? 1 : 0;
        u.eid = e; u.bofs = (size_t)e * estride; return true;
    }
    __device__ __forceinline__ void a_ready(const Unit&) const {}
    __device__ __forceinline__ void done(const Unit&) const {}
};

typedef float f32x2 __attribute__((ext_vector_type(2))); typedef __bf16 bf16x2_t __attribute__((ext_vector_type(2)));
__device__ __forceinline__ unsigned cvt_pk_bf16(float lo, float hi) { f32x2 v = {lo, hi}; bf16x2_t b = __builtin_convertvector(v, bf16x2_t); return __builtin_bit_cast(unsigned, b); }
__device__ __forceinline__ float silu_mul(float g, float u) { return g * u * __builtin_amdgcn_rcpf(1.f + __builtin_amdgcn_exp2f(-1.4426950408889634f * g)); }
struct EpiScaleBf16I8 {
    static constexpr bool PERM = true, AFTER_DRAIN = false, I8 = true, PREF = false; typedef i32x4 acc_t;
    bf16_t* O; int ldc; const float* rs; const unsigned* cmax; int ncol;
    __device__ __forceinline__ void operator()(const i32x4 (&acc)[2][2][4][2], const Unit& u, int wr, int wc, int fr, int fq) const {
        const int row0 = u.pm * BM + wr * 64 + fr, col0 = u.pn * BM + wc * 32 + 8 * fq;
        const unsigned* cm = cmax + (size_t)u.eid * ncol + col0;
        f32x4 sc[2][2];
#pragma unroll
        for (int bj = 0; bj < 2; ++bj)
#pragma unroll
            for (int n = 0; n < 2; ++n) sc[bj][n] = __builtin_bit_cast(f32x4, *(const u32x4*)(cm + bj * HALF + 4 * n)) * (1.f / 127.f);
#pragma unroll
        for (int ai = 0; ai < 2; ++ai)
#pragma unroll
            for (int m = 0; m < 4; ++m) { const int r = row0 + ai * HALF + m * 16; const float sa = rs[r]; bf16_t* rowp = O + (size_t)r * ldc + col0;
#pragma unroll
                for (int bj = 0; bj < 2; ++bj) { const f32x4 v0 = __builtin_convertvector(acc[ai][bj][m][0], f32x4) * (sc[bj][0] * sa), v1 = __builtin_convertvector(acc[ai][bj][m][1], f32x4) * (sc[bj][1] * sa);
                    u32x4 w; w.x = cvt_pk_bf16(v0[0], v0[1]); w.y = cvt_pk_bf16(v0[2], v0[3]); w.z = cvt_pk_bf16(v1[0], v1[1]); w.w = cvt_pk_bf16(v1[2], v1[3]);
                    *(u32x4*)(rowp + bj * HALF) = w; } }
    }
};
__device__ __forceinline__ void ld_base8i(const float* base32, const bf16_t* base16, size_t off, f32x4& b0, f32x4& b1) {
    if (base32) { b0 = *(const f32x4*)(base32 + off); b1 = *(const f32x4*)(base32 + off + 4); }
    else { const u32x4 w = *(const u32x4*)(base16 + off);
        b0 = (f32x4){__builtin_bit_cast(float, w.x << 16), __builtin_bit_cast(float, w.x & 0xffff0000u), __builtin_bit_cast(float, w.y << 16), __builtin_bit_cast(float, w.y & 0xffff0000u)};
        b1 = (f32x4){__builtin_bit_cast(float, w.z << 16), __builtin_bit_cast(float, w.z & 0xffff0000u), __builtin_bit_cast(float, w.w << 16), __builtin_bit_cast(float, w.w & 0xffff0000u)}; }
}
struct EpiResidI8 {
    static constexpr bool PERM = true, AFTER_DRAIN = false, I8 = true, PREF = false; static constexpr int NSTORE = 0; typedef i32x4 acc_t;
    const float* base32; const bf16_t* base; bf16_t* out; const float* rs; const unsigned* cmax;
    __device__ __forceinline__ void operator()(const i32x4 (&acc)[2][2][4][2], const Unit& u, int wr, int wc, int fr, int fq) const {
        const int row0 = u.pm * BM + wr * 64 + fr, col0 = u.pn * BM + wc * 32 + 8 * fq;
        const unsigned* cm = cmax + col0;
        f32x4 sc[2][2];
#pragma unroll
        for (int bj = 0; bj < 2; ++bj)
#pragma unroll
            for (int n = 0; n < 2; ++n) sc[bj][n] = __builtin_bit_cast(f32x4, *(const u32x4*)(cm + bj * HALF + 4 * n)) * (1.f / 127.f);
#pragma unroll
        for (int ai = 0; ai < 2; ++ai)
#pragma unroll
            for (int m = 0; m < 4; ++m) { const int r = row0 + ai * HALF + m * 16; const float sa = rs[r];
#pragma unroll
                for (int bj = 0; bj < 2; ++bj) { const size_t off = (size_t)r * 2048 + col0 + bj * HALF; f32x4 b0, b1; ld_base8i(base32, base, off, b0, b1);
                    const f32x4 v0 = b0 + __builtin_convertvector(acc[ai][bj][m][0], f32x4) * (sc[bj][0] * sa), v1 = b1 + __builtin_convertvector(acc[ai][bj][m][1], f32x4) * (sc[bj][1] * sa);
                    u32x4 w; w.x = cvt_pk_bf16(v0[0], v0[1]); w.y = cvt_pk_bf16(v0[2], v0[3]); w.z = cvt_pk_bf16(v1[0], v1[1]); w.w = cvt_pk_bf16(v1[2], v1[3]);
                    *(u32x4*)(out + off) = w; } }
    }
};
constexpr float EPSN = 1e-6f;
template <int MODE> __device__ __forceinline__ float rowscale(const float* p, int r, int fq) {
    if constexpr (MODE == 0) { return 1.f; }
    else if constexpr (MODE == 1) { const f32x4 a = *(const f32x4*)(p + (size_t)r * 32 + 8 * fq), b = *(const f32x4*)(p + (size_t)r * 32 + 8 * fq + 4);
        float s = ((a[0] + a[1]) + (a[2] + a[3])) + ((b[0] + b[1]) + (b[2] + b[3])); s += __shfl_xor(s, 16); s += __shfl_xor(s, 32); return rsqrtf(s * (1.f / 2048.f) + EPSN); }
    else if constexpr (MODE == 2) { const f32x4 a = *(const f32x4*)(p + (size_t)r * 16 + 4 * fq);
        float s = (a[0] + a[1]) + (a[2] + a[3]); s += __shfl_xor(s, 16); s += __shfl_xor(s, 32); return rsqrtf(s * (1.f / 1024.f) + EPSN); }
    else { return p[r]; }
}
__device__ __forceinline__ void ld_base8(const float* base32, const bf16_t* base16, size_t off, f32x4& b0, f32x4& b1) {
    if (base32) { b0 = *(const f32x4*)(base32 + off); b1 = *(const f32x4*)(base32 + off + 4); }
    else { const u32x4 w = *(const u32x4*)(base16 + off);
        b0 = (f32x4){__builtin_bit_cast(float, w.x << 16), __builtin_bit_cast(float, w.x & 0xffff0000u), __builtin_bit_cast(float, w.y << 16), __builtin_bit_cast(float, w.y & 0xffff0000u)};
        b1 = (f32x4){__builtin_bit_cast(float, w.z << 16), __builtin_bit_cast(float, w.z & 0xffff0000u), __builtin_bit_cast(float, w.w << 16), __builtin_bit_cast(float, w.w & 0xffff0000u)}; }
}
template <int MODE> struct EpiResidB {
    static constexpr bool PERM = true, AFTER_DRAIN = false, I8 = false, PREF = false; typedef f32x4 acc_t;
    const float* base32; const bf16_t* base16; bf16_t* out; const float* sp;
    __device__ __forceinline__ void operator()(const f32x4 (&acc)[2][2][4][2], const Unit& u, int wr, int wc, int fr, int fq) const {
        const int row0 = u.pm * BM + wr * 64 + fr, col0 = u.pn * BM + wc * 32 + 8 * fq;
#pragma unroll
        for (int ai = 0; ai < 2; ++ai)
#pragma unroll
            for (int m = 0; m < 4; ++m) { const int r = row0 + ai * HALF + m * 16; const float sc = rowscale<MODE>(sp, r, fq);
#pragma unroll
                for (int bj = 0; bj < 2; ++bj) { const size_t off = (size_t)r * 2048 + col0 + bj * HALF; f32x4 b0, b1; ld_base8(base32, base16, off, b0, b1);
                    const f32x4 v0 = b0 + acc[ai][bj][m][0] * sc, v1 = b1 + acc[ai][bj][m][1] * sc;
                    u32x4 w; w.x = cvt_pk_bf16(v0[0], v0[1]); w.y = cvt_pk_bf16(v0[2], v0[3]); w.z = cvt_pk_bf16(v1[0], v1[1]); w.w = cvt_pk_bf16(v1[2], v1[3]);
                    *(u32x4*)(out + off) = w; } }
    }
};
struct EpiSwigluI8 {
    static constexpr bool PERM = true, AFTER_DRAIN = false, I8 = true, PREF = false; typedef i32x4 acc_t;
    bf16_t* O; int ldc; const float* as; const unsigned* cmax; int ncol;
    __device__ __forceinline__ void operator()(const i32x4 (&acc)[2][2][4][2], const Unit& u, int wr, int wc, int fr, int fq) const {
        const int row0 = u.pm * BM + wr * 64 + fr, col0 = u.pn * HALF + wc * 32 + 8 * fq;
        const unsigned* cm = cmax + (size_t)u.eid * ncol + u.pn * BM + wc * 32 + 8 * fq;
        f32x4 sg[2], su[2];
#pragma unroll
        for (int n = 0; n < 2; ++n) { const u32x4 a = *(const u32x4*)(cm + 4 * n), b = *(const u32x4*)(cm + HALF + 4 * n);
            sg[n] = __builtin_bit_cast(f32x4, a) * (1.f / 127.f); su[n] = __builtin_bit_cast(f32x4, b) * (1.f / 127.f); }
#pragma unroll
        for (int ai = 0; ai < 2; ++ai)
#pragma unroll
            for (int m = 0; m < 4; ++m) { const int r = row0 + ai * HALF + m * 16; const float sa = as[r];
                const f32x4 g0 = __builtin_convertvector(acc[ai][0][m][0], f32x4) * (sg[0] * sa), g1 = __builtin_convertvector(acc[ai][0][m][1], f32x4) * (sg[1] * sa);
                const f32x4 u0 = __builtin_convertvector(acc[ai][1][m][0], f32x4) * (su[0] * sa), u1 = __builtin_convertvector(acc[ai][1][m][1], f32x4) * (su[1] * sa);
                u32x4 w; w.x = cvt_pk_bf16(silu_mul(g0[0], u0[0]), silu_mul(g0[1], u0[1])); w.y = cvt_pk_bf16(silu_mul(g0[2], u0[2]), silu_mul(g0[3], u0[3]));
                w.z = cvt_pk_bf16(silu_mul(g1[0], u1[0]), silu_mul(g1[1], u1[1])); w.w = cvt_pk_bf16(silu_mul(g1[2], u1[2]), silu_mul(g1[3], u1[3]));
                *(u32x4*)(O + (size_t)r * ldc + col0) = w; }
    }
};

constexpr int PREF_OFF = 131072;
__device__ __forceinline__ void pref_issue(const float* rs_rows, const unsigned* cm_cols, PG8_LAS unsigned char* lds, int buf, int wid, int lane) {
    asm volatile("" : "+v"(lane));
    const void* src = (wid < 4) ? (const void*)(rs_rows + wid * 64 + lane) : (const void*)(cm_cols + (wid - 4) * 64 + lane);
    __builtin_amdgcn_global_load_lds((const unsigned*)src, (PG8_LAS unsigned*)(lds + PREF_OFF + buf * 2048 + wid * 256), 4, 0, 0);
}
struct EpiScaleBf16I8P {
    static constexpr bool PERM = true, AFTER_DRAIN = false, I8 = true, PREF = true; typedef i32x4 acc_t;
    bf16_t* O; int ldc; const float* rs; const unsigned* cmax; int ncol;
    __device__ __forceinline__ void prefetch(const Unit& u, PG8_LAS unsigned char* lds, int buf, int wid, int lane) const { pref_issue(rs + (size_t)u.pm * BM, cmax + (size_t)u.eid * ncol + u.pn * BM, lds, buf, wid, lane); }
    __device__ __forceinline__ void operator()(const i32x4 (&acc)[2][2][4][2], const Unit& u, int wr, int wc, int fr, int fq, PG8_LAS unsigned char* lds, int buf) const {
        const int row0 = u.pm * BM + wr * 64 + fr, col0 = u.pn * BM + wc * 32 + 8 * fq;
        const PG8_LAS float* rsl = (const PG8_LAS float*)(lds + PREF_OFF + buf * 2048) + wr * 64 + fr; const PG8_LAS unsigned* cml = (const PG8_LAS unsigned*)(lds + PREF_OFF + buf * 2048 + 1024) + wc * 32 + 8 * fq;
        f32x4 sc[2][2];
#pragma unroll
        for (int bj = 0; bj < 2; ++bj)
#pragma unroll
            for (int n = 0; n < 2; ++n) sc[bj][n] = __builtin_bit_cast(f32x4, *(const PG8_LAS u32x4*)(cml + bj * HALF + 4 * n)) * (1.f / 127.f);
#pragma unroll
        for (int ai = 0; ai < 2; ++ai)
#pragma unroll
            for (int m = 0; m < 4; ++m) { const int r = row0 + ai * HALF + m * 16; const float sa = rsl[ai * HALF + m * 16]; bf16_t* rowp = O + (size_t)r * ldc + col0;
#pragma unroll
                for (int bj = 0; bj < 2; ++bj) { const f32x4 v0 = __builtin_convertvector(acc[ai][bj][m][0], f32x4) * (sc[bj][0] * sa), v1 = __builtin_convertvector(acc[ai][bj][m][1], f32x4) * (sc[bj][1] * sa);
                    u32x4 w; w.x = cvt_pk_bf16(v0[0], v0[1]); w.y = cvt_pk_bf16(v0[2], v0[3]); w.z = cvt_pk_bf16(v1[0], v1[1]); w.w = cvt_pk_bf16(v1[2], v1[3]);
                    *(u32x4*)(rowp + bj * HALF) = w; } }
    }
};
struct EpiSwigluI8P {
    static constexpr bool PERM = true, AFTER_DRAIN = false, I8 = true, PREF = true; typedef i32x4 acc_t;
    bf16_t* O; int ldc; const float* as; const unsigned* cmax; int ncol;
    __device__ __forceinline__ void prefetch(const Unit& u, PG8_LAS unsigned char* lds, int buf, int wid, int lane) const { pref_issue(as + (size_t)u.pm * BM, cmax + (size_t)u.eid * ncol + u.pn * BM, lds, buf, wid, lane); }
    __device__ __forceinline__ void operator()(const i32x4 (&acc)[2][2][4][2], const Unit& u, int wr, int wc, int fr, int fq, PG8_LAS unsigned char* lds, int buf) const {
        const int row0 = u.pm * BM + wr * 64 + fr, col0 = u.pn * HALF + wc * 32 + 8 * fq;
        const PG8_LAS float* rsl = (const PG8_LAS float*)(lds + PREF_OFF + buf * 2048) + wr * 64 + fr; const PG8_LAS unsigned* cml = (const PG8_LAS unsigned*)(lds + PREF_OFF + buf * 2048 + 1024) + wc * 32 + 8 * fq;
        f32x4 sg[2], su[2];
#pragma unroll
        for (int n = 0; n < 2; ++n) { sg[n] = __builtin_bit_cast(f32x4, *(const PG8_LAS u32x4*)(cml + 4 * n)) * (1.f / 127.f); su[n] = __builtin_bit_cast(f32x4, *(const PG8_LAS u32x4*)(cml + HALF + 4 * n)) * (1.f / 127.f); }
#pragma unroll
        for (int ai = 0; ai < 2; ++ai)
#pragma unroll
            for (int m = 0; m < 4; ++m) { const int r = row0 + ai * HALF + m * 16; const float sa = rsl[ai * HALF + m * 16];
                const f32x4 g0 = __builtin_convertvector(acc[ai][0][m][0], f32x4) * (sg[0] * sa), g1 = __builtin_convertvector(acc[ai][0][m][1], f32x4) * (sg[1] * sa);
                const f32x4 u0 = __builtin_convertvector(acc[ai][1][m][0], f32x4) * (su[0] * sa), u1 = __builtin_convertvector(acc[ai][1][m][1], f32x4) * (su[1] * sa);
                u32x4 w; w.x = cvt_pk_bf16(silu_mul(g0[0], u0[0]), silu_mul(g0[1], u0[1])); w.y = cvt_pk_bf16(silu_mul(g0[2], u0[2]), silu_mul(g0[3], u0[3]));
                w.z = cvt_pk_bf16(silu_mul(g1[0], u1[0]), silu_mul(g1[1], u1[1])); w.w = cvt_pk_bf16(silu_mul(g1[2], u1[2]), silu_mul(g1[3], u1[3]));
                *(u32x4*)(O + (size_t)r * ldc + col0) = w; }
    }
};
template <bool I8, class AccT> __device__ __forceinline__ AccT mma16(bf16x8 a, bf16x8 b, AccT c) {
    if constexpr (I8) return __builtin_amdgcn_mfma_i32_16x16x64_i8(__builtin_bit_cast(i32x4, a), __builtin_bit_cast(i32x4, b), c, 0, 0, 0);
    else return __builtin_amdgcn_mfma_f32_16x16x32_bf16(a, b, c, 0, 0, 0);
}
template <class Epi, class Sched, bool ALIGN_EPI = false, bool SP2 = false>
__device__ __forceinline__ void gemm_phase(PG8_LAS unsigned char* lds, const Gemm g, const Sched& S, const Epi& E) {
    int tid_ = threadIdx.x; asm volatile("" : "+v"(tid_));
    const int tid = tid_, wid = __builtin_amdgcn_readfirstlane(tid >> 6), lane = tid & 63, wr = wid >> 2, wc = wid & 3, fr = lane & 15, fq = lane >> 4;
    const int K = g.K, nt = K / BK;
    unsigned voffA[2], voffB[2];
#pragma unroll
    for (int i = 0; i < 2; ++i) { int R, C; stage_rc(tid * 16 + i * 8192, R, C); const int Rb = Epi::PERM ? ((R & ~31) + perm32(R & 31)) : R;
        voffA[i] = (unsigned)(R * K + C) * 2u; voffB[i] = (unsigned)(Rb * K + C) * 2u; }
    const size_t kstep = (size_t)(BK * 2);
    const size_t hstep = (size_t)HALF * K * 2;
    const size_t tstep = 2 * hstep;
    const unsigned ldsw = (unsigned)wid * 1024u;
    const int aoff = lds_byte(wr * 64 + fr, fq * 8), boff = lds_byte(wc * 32 + fr, fq * 8);
#define PG8_SA(b, h) (((b) * 2 + (h)) * HTB)
#define PG8_SB(b, h) ((4 + (b) * 2 + (h)) * HTB)
#define PG8_STAGE(bufoff, gbase, voff) do { _Pragma("unroll") for (int _i = 0; _i < 2; ++_i) \
        __builtin_amdgcn_global_load_lds((const unsigned*)((const char*)(gbase) + (voff)[_i]), (PG8_LAS unsigned*)(lds + (bufoff) + ldsw + _i * 8192), 16, 0, 0); } while (0)
#define PG8_LDA(dst, b, h) do { _Pragma("unroll") for (int m = 0; m < 4; ++m) _Pragma("unroll") for (int k = 0; k < 2; ++k) dst[m][k] = *(const PG8_LAS bf16x8*)(lds + PG8_SA(b, h) + aoff + m * 2048 + k * 1024); } while (0)
#define PG8_LDB(dst, b, h) do { _Pragma("unroll") for (int n = 0; n < 2; ++n) _Pragma("unroll") for (int k = 0; k < 2; ++k) dst[n][k] = *(const PG8_LAS bf16x8*)(lds + PG8_SB(b, h) + boff + n * 2048 + k * 1024); } while (0)
#define PG8_MMA(ai, bj, At, Bt) do { __builtin_amdgcn_s_setprio(1); _Pragma("unroll") for (int m = 0; m < 4; ++m) _Pragma("unroll") for (int n = 0; n < 2; ++n) _Pragma("unroll") for (int k = 0; k < 2; ++k) \
        acc[ai][bj][m][n] = mma16<Epi::I8>(Bt[n][k], At[m][k], acc[ai][bj][m][n]); __builtin_amdgcn_s_setprio(0); } while (0)
#define PG8_WAIT_V(n) asm volatile("s_waitcnt vmcnt(" #n ")" ::: "memory")
#define PG8_WAIT_L(n) asm volatile("s_waitcnt lgkmcnt(" #n ")" ::: "memory")
#define PG8_BAR __builtin_amdgcn_s_barrier()
#define PG8_SCHED __builtin_amdgcn_sched_barrier(0)
    Unit cur, nxt; int ui = 0;
    if (!S.next(0, cur)) return;
    typedef typename Epi::acc_t acc_t; acc_t acc[2][2][4][2];
#pragma unroll
    for (int a = 0; a < 2; ++a)
#pragma unroll
        for (int b = 0; b < 2; ++b)
#pragma unroll
            for (int m = 0; m < 4; ++m)
#pragma unroll
                for (int n = 0; n < 2; ++n) acc[a][b][m][n] = acc_t{};
    bf16x8 At[4][2], B0[2][2], B1[2][2];
    const char* cA = (const char*)g.A + (size_t)cur.pm * tstep; const char* cB = (const char*)g.Bt + cur.bofs + (size_t)cur.pn * tstep;
    S.a_ready(cur);
    int ubuf = 0;
    if constexpr (Epi::PREF) E.prefetch(cur, lds, ubuf, wid, lane);
    if constexpr (SP2) {
        PG8_STAGE(PG8_SB(0, 0), cB, voffB); PG8_STAGE(PG8_SB(0, 1), cB + hstep, voffB); PG8_STAGE(PG8_SA(0, 0), cA, voffA); PG8_STAGE(PG8_SA(0, 1), cA + hstep, voffA);
        if (wr == 1) PG8_BAR;
        PG8_WAIT_V(2); PG8_BAR;
        PG8_STAGE(PG8_SB(1, 0), cB + kstep, voffB); PG8_STAGE(PG8_SA(1, 0), cA + kstep, voffA); PG8_STAGE(PG8_SB(1, 1), cB + hstep + kstep, voffB);
        PG8_WAIT_V(6); PG8_BAR;
    } else {
        PG8_STAGE(PG8_SB(0, 0), cB, voffB); PG8_STAGE(PG8_SA(0, 0), cA, voffA); PG8_STAGE(PG8_SB(0, 1), cB + hstep, voffB); PG8_STAGE(PG8_SA(0, 1), cA + hstep, voffA);
        if (wr == 1) PG8_BAR;
        PG8_WAIT_V(4); PG8_BAR;
        PG8_STAGE(PG8_SB(1, 0), cB + kstep, voffB); PG8_STAGE(PG8_SA(1, 0), cA + kstep, voffA); PG8_STAGE(PG8_SB(1, 1), cB + hstep + kstep, voffB);
        PG8_WAIT_V(6); PG8_BAR;
    }
    for (;;) {
        const bool has_next = S.next(ui + 1, nxt);
        const char* nA = has_next ? (const char*)g.A + (size_t)nxt.pm * tstep : cA; const char* nB = has_next ? (const char*)g.Bt + nxt.bofs + (size_t)nxt.pn * tstep : cB;
        for (int t = 0; t < nt; t += 2) {
            const bool last = (t == nt - 2);
            const char* a1 = cA + (size_t)(t + 1) * kstep;
            const char* a2 = last ? nA : cA + (size_t)(t + 2) * kstep; const char* b2 = last ? nB : cB + (size_t)(t + 2) * kstep;
            const char* a3 = a2 + kstep; const char* b3 = b2 + kstep;
            if (last && has_next) S.a_ready(nxt);
            if constexpr (SP2) {
            PG8_LDB(B0, 0, 0); PG8_LDB(B1, 0, 1); PG8_SCHED; PG8_LDA(At, 0, 0); PG8_STAGE(PG8_SA(1, 1), a1 + hstep, voffA);
            PG8_WAIT_V(8); PG8_WAIT_L(0); PG8_BAR; PG8_MMA(0, 0, At, B0); PG8_MMA(0, 1, At, B1); PG8_BAR; PG8_SCHED;
            PG8_LDA(At, 0, 1); PG8_STAGE(PG8_SB(0, 0), b2, voffB); PG8_STAGE(PG8_SB(0, 1), b2 + hstep, voffB); PG8_STAGE(PG8_SA(0, 0), a2, voffA);
            PG8_WAIT_V(8); PG8_WAIT_L(0); PG8_BAR; PG8_MMA(1, 0, At, B0); PG8_MMA(1, 1, At, B1); PG8_BAR; PG8_SCHED;
            PG8_LDB(B0, 1, 0); PG8_LDB(B1, 1, 1); PG8_SCHED; PG8_LDA(At, 1, 0); PG8_STAGE(PG8_SA(0, 1), a2 + hstep, voffA);
            PG8_WAIT_V(8); PG8_WAIT_L(0); PG8_BAR; PG8_MMA(0, 0, At, B0); PG8_MMA(0, 1, At, B1); PG8_BAR; PG8_SCHED;
            PG8_LDA(At, 1, 1); PG8_STAGE(PG8_SB(1, 0), b3, voffB); PG8_STAGE(PG8_SB(1, 1), b3 + hstep, voffB); PG8_STAGE(PG8_SA(1, 0), a3, voffA);
            PG8_WAIT_V(8); PG8_WAIT_L(0); PG8_BAR; PG8_MMA(1, 0, At, B0); PG8_MMA(1, 1, At, B1); PG8_BAR; PG8_SCHED;
            } else {
            PG8_LDB(B0, 0, 0); PG8_SCHED; PG8_LDA(At, 0, 0); PG8_STAGE(PG8_SA(1, 1), a1 + hstep, voffA);
            PG8_WAIT_L(8); PG8_BAR; PG8_WAIT_L(0); PG8_MMA(0, 0, At, B0); PG8_BAR; PG8_SCHED;
            PG8_LDB(B1, 0, 1); PG8_STAGE(PG8_SB(0, 0), b2, voffB);
            PG8_BAR; PG8_WAIT_L(0); PG8_MMA(0, 1, At, B1); PG8_BAR;
            PG8_LDA(At, 0, 1); PG8_STAGE(PG8_SA(0, 0), a2, voffA);
            PG8_BAR; PG8_WAIT_L(0); PG8_MMA(1, 0, At, B0); PG8_BAR; PG8_SCHED;
            PG8_STAGE(PG8_SB(0, 1), b2 + hstep, voffB);
            PG8_WAIT_V(6); PG8_BAR; PG8_MMA(1, 1, At, B1); PG8_BAR;
            PG8_LDB(B0, 1, 0); PG8_SCHED; PG8_LDA(At, 1, 0); PG8_STAGE(PG8_SA(0, 1), a2 + hstep, voffA);
            PG8_WAIT_L(8); PG8_BAR; PG8_WAIT_L(0); PG8_MMA(0, 0, At, B0); PG8_BAR; PG8_SCHED;
            PG8_LDB(B1, 1, 1); PG8_STAGE(PG8_SB(1, 0), b3, voffB);
            PG8_BAR; PG8_WAIT_L(0); PG8_MMA(0, 1, At, B1); PG8_BAR;
            PG8_LDA(At, 1, 1); PG8_STAGE(PG8_SA(1, 0), a3, voffA);
            PG8_BAR; PG8_WAIT_L(0); PG8_MMA(1, 0, At, B0); PG8_BAR; PG8_SCHED;
            PG8_STAGE(PG8_SB(1, 1), b3 + hstep, voffB);
            PG8_WAIT_V(6); PG8_BAR; PG8_MMA(1, 1, At, B1); PG8_BAR;
            }
        }
        if constexpr (ALIGN_EPI) { if (wr == 0) PG8_BAR; }
        if constexpr (!Epi::AFTER_DRAIN) { if constexpr (Epi::PREF) E(acc, cur, wr, wc, fr, fq, lds, ubuf); else E(acc, cur, wr, wc, fr, fq); S.done(cur); }
        if (!has_next) break;
#pragma unroll
        for (int a = 0; a < 2; ++a)
#pragma unroll
            for (int b = 0; b < 2; ++b)
#pragma unroll
                for (int m = 0; m < 4; ++m)
#pragma unroll
                    for (int n = 0; n < 2; ++n) acc[a][b][m][n] = acc_t{};
        cur = nxt; cA = nA; cB = nB; ++ui;
        if constexpr (Epi::PREF) { ubuf ^= 1; E.prefetch(cur, lds, ubuf, wid, lane); }
        if constexpr (ALIGN_EPI) { if (wr == 1) PG8_BAR; }
    }
    PG8_WAIT_V(0);
    if constexpr (!ALIGN_EPI) { if (wr == 0) PG8_BAR; }
    PG8_BAR;
    if constexpr (Epi::AFTER_DRAIN) { E.fused(acc, cur, wr, wc, fr, fq, lds, wid, lane); S.done(cur); }
#undef PG8_SA
#undef PG8_SB
#undef PG8_STAGE
#undef PG8_LDA
#undef PG8_LDB
#undef PG8_MMA
#undef PG8_WAIT_V
#undef PG8_WAIT_L
#undef PG8_BAR
#undef PG8_SCHED
}
}
#ifndef PG8_SP2
#define PG8_SP2 true
#endif
#ifndef PG8_ALIGN
#define PG8_ALIGN true
#endif
constexpr int NWAVES = 8;
constexpr int BATCH = 4, SEQ = 4096, T = BATCH * SEQ, D = 2048, DIN = 3840, DFF = 5632, DE = 2816, NE = 8;
constexpr int C_Q = 0, C_K = 1024, C_V = 1152, C_CB = 1280, C_CC = 1792, C_CX = 2304, C_LX = 2816, C_LG = 3328;
constexpr int MAXP = 136, MROWS = MAXP * 256;
constexpr float EPS = 1e-6f, LOG2E = 1.4426950408889634f;
constexpr int N_PHASES = 20;
constexpr size_t MiB = 1u << 20, KiB = 1u << 10;
constexpr size_t WS_CTL = 0, CTL_ZERO_BYTES = 1 * MiB;
constexpr size_t WS_CMAX = 256 * KiB;
constexpr int CM_GU = 0, CM_EGU = 2 * DFF, CM_IN = CM_EGU + 8 * 2 * DE, CM_OUT = CM_IN + 2 * DIN, CM_D = CM_OUT + 2 * D, CM_ED = CM_D + D, CM_END = CM_ED + 8 * D;
constexpr size_t WS_SSQA = 3 * MiB;
constexpr size_t WS_LSUM = 4 * MiB;
constexpr size_t WS_AS = 5 * MiB;
constexpr size_t WS_TOKE = WS_AS + 64 * KiB;
constexpr size_t WS_TOKW = WS_TOKE + 64 * KiB;
constexpr size_t WS_LRANK = WS_TOKW + 128 * KiB;
constexpr size_t WS_POS = WS_LRANK + 64 * KiB;
constexpr size_t WS_BLKCNT = WS_POS + 128 * KiB;
constexpr size_t WS_SEG = WS_BLKCNT + 8 * KiB;
constexpr size_t WS_ASS = 6 * MiB;
constexpr size_t WS_GWS = WS_ASS + 256 * KiB;
constexpr size_t WS_ASM = WS_GWS + 256 * KiB;
constexpr size_t WS_ASD = WS_ASM + 64 * KiB;
constexpr size_t WS_ASDM = WS_ASD + 64 * KiB;
constexpr size_t WS_RWT = 8 * MiB;
constexpr size_t WS_WAT = 7 * MiB;
constexpr size_t WS_WXT = WS_WAT + 128 * KiB;
constexpr size_t WS_WIN = 17 * MiB;
constexpr size_t WS_WOUT = 32 * MiB;
constexpr size_t WS_WGU = 48 * MiB;
constexpr size_t WS_WD = 70 * MiB;
constexpr size_t WS_EGU = 81 * MiB;
constexpr size_t WS_ED = 169 * MiB;
constexpr size_t WS_XB = 213 * MiB;
constexpr size_t WS_XA = 277 * MiB;
constexpr size_t WS_XQ8 = 341 * MiB;
constexpr size_t WS_PROJ = 373 * MiB;
constexpr size_t WS_AMIXB = 493 * MiB;
constexpr size_t WS_AMIX8 = 525 * MiB;
constexpr size_t WS_HL = 557 * MiB;
constexpr size_t WS_PL = 573 * MiB;
constexpr size_t WS_WOF = 557 * MiB;
constexpr size_t WS_ACT = 373 * MiB;
constexpr size_t WS_ACT8 = 557 * MiB;
constexpr size_t WS_XP = 373 * MiB;
constexpr size_t WS_ACTM = 441 * MiB;
constexpr size_t WS_ACTM8 = 628 * MiB;
constexpr size_t WS_Y = 373 * MiB;
constexpr size_t WS_END = 722 * MiB;
static_assert(WS_CMAX + (size_t)CM_END * 4 <= CTL_ZERO_BYTES, "cmax");
static_assert(WS_WIN + 2ull * DIN * D <= WS_WOUT && WS_WOUT + 2ull * D * D * 2 <= WS_WGU && WS_WGU + 2ull * DFF * D <= WS_WD && WS_WD + (size_t)D * DFF <= WS_EGU && WS_EGU + 8ull * 2 * DE * D <= WS_ED && WS_ED + 8ull * D * DE <= WS_XB, "ws map 1");
static_assert(WS_XB + (size_t)T * D * 2 <= WS_XA && WS_XA + (size_t)T * D * 2 <= WS_XQ8 && WS_XQ8 + (size_t)T * D <= WS_PROJ && WS_PROJ + (size_t)T * DIN * 2 <= WS_AMIXB && WS_AMIXB + (size_t)T * 1024 * 2 <= WS_AMIX8 && WS_AMIX8 + (size_t)T * D <= WS_ACT8 && WS_WOF + 2ull * D * D * 4 <= WS_END, "ws map 2");
static_assert(WS_ACT + (size_t)T * DFF * 2 <= WS_ACT8 && WS_ACT8 + (size_t)T * DFF <= WS_END && WS_XP + (size_t)MROWS * D <= WS_ACTM && WS_ACTM + (size_t)MROWS * DE * 2 <= WS_ACTM8 && WS_ACTM8 + (size_t)MROWS * DE <= WS_END && WS_Y + (size_t)MROWS * D * 2 <= WS_ACTM8, "ws map 3");
constexpr int CW_BAR = 4096;
constexpr int RING_BYTES = 131072, LDSCTL_OFF = 143360, MISC_OFF = LDSCTL_OFF + 320, LDS_BYTES = 147456;
constexpr int LRU_WREG = 17408;
static_assert(8 * LRU_WREG <= LDSCTL_OFF, "LRU scratch");

#define GAS __attribute__((address_space(1)))
#define LAS __attribute__((address_space(3)))
typedef unsigned short bf16;
typedef unsigned v4u __attribute__((ext_vector_type(4)));
typedef unsigned v2u __attribute__((ext_vector_type(2)));
typedef float f32x4 __attribute__((ext_vector_type(4)));
typedef float f32x16 __attribute__((ext_vector_type(16)));
typedef short bf16x8 __attribute__((ext_vector_type(8)));
typedef GAS unsigned gu32;
#define RLX_AGENT __ATOMIC_RELAXED, __HIP_MEMORY_SCOPE_AGENT
#define LDS_WAIT() asm volatile("s_waitcnt lgkmcnt(0)" ::: "memory")
#define MFMA32(a, b, c) __builtin_amdgcn_mfma_f32_32x32x16_bf16((a), (b), (c), 0, 0, 0)
__device__ __forceinline__ unsigned f2bf(float f) { unsigned u = __builtin_bit_cast(unsigned, f); return (u + 0x7fffu + ((u >> 16) & 1u)) >> 16; }
__device__ __forceinline__ unsigned pk2(float lo, float hi) { return pg8::cvt_pk_bf16(lo, hi); }
__device__ __forceinline__ float bflo(unsigned w) { return __builtin_bit_cast(float, w << 16); }
__device__ __forceinline__ float bfhi(unsigned w) { return __builtin_bit_cast(float, w & 0xffff0000u); }
__device__ __forceinline__ float bf1(bf16 h) { return __builtin_bit_cast(float, (unsigned)h << 16); }
__device__ __forceinline__ float wave_sum(float v) {
#pragma unroll
    for (int o = 1; o < 64; o <<= 1) v += __shfl_xor(v, o);
    return v;
}
__device__ __forceinline__ int wave_sum_i(int v) {
#pragma unroll
    for (int o = 1; o < 64; o <<= 1) v += __shfl_xor(v, o);
    return v;
}
__device__ __forceinline__ float sigmoidf_(float x) { return __builtin_amdgcn_rcpf(1.f + __builtin_amdgcn_exp2f(-LOG2E * x)); }

#define XB_TMO      128
#define XB_XCNT(j)  (256  + 64 * (j))
#define XB_XSUB(j)  (1280 + 64 * (j))
#define XB_XGEN(j)  (2304 + 64 * (j))
#define XB_TOP      3328
#define XB_TOPGEN   3392
#define XCD_BAR_WORDS 3456
#define XB_SPIN_CAP (1u << 22)
__device__ __forceinline__ unsigned xb_ld(unsigned* p)              { return __hip_atomic_load(p, __ATOMIC_RELAXED, __HIP_MEMORY_SCOPE_AGENT); }
__device__ __forceinline__ unsigned xb_add(unsigned* p, unsigned v) { return __hip_atomic_fetch_add(p, v, __ATOMIC_RELAXED, __HIP_MEMORY_SCOPE_AGENT); }
__device__ __forceinline__ unsigned xb_xcc_id() { return (unsigned)__builtin_amdgcn_s_getreg((3 << 11) | 20) & 0xFu; }
#define XB_SPIN(cond, bar) do { unsigned _sp = 0; while (cond) { __builtin_amdgcn_s_sleep(1); \
    if ((++_sp & 255u) == 0u) { if (xb_ld(&(bar)[XB_TMO])) break; if (_sp > XB_SPIN_CAP) { atomicAdd(&(bar)[XB_TMO], 1u); break; } } } } while (0)
struct XcdBarrier { unsigned* bar; unsigned x; volatile LAS unsigned* st; };
__device__ __forceinline__ XcdBarrier xcd_barrier_post(unsigned* bar, volatile LAS unsigned* st) {
    XcdBarrier b; b.bar = bar; b.x = xb_xcc_id(); b.st = st;
    if (threadIdx.x == 0) (void)xb_add(&bar[XB_XCNT(b.x)], 1u);
    return b;
}
__device__ __forceinline__ void xcd_barrier_complete(unsigned* bar, unsigned x, unsigned& nloc, unsigned& nx) {
    const unsigned G = gridDim.x * gridDim.y * gridDim.z;
    unsigned sum, cnt, mine, sp = 0u;
    for (;;) {
        sum = 0u; cnt = 0u; mine = 0u;
#pragma unroll
        for (unsigned j = 0; j < 16; ++j) { const unsigned c = xb_ld(&bar[XB_XCNT(j)]); sum += c; cnt += (c > 0u) ? 1u : 0u; mine = (j == x) ? c : mine; }
        if (sum == G) break;
        __builtin_amdgcn_s_sleep(1);
        if ((++sp & 255u) == 0u) { if (xb_ld(&bar[XB_TMO])) break; if (sp > XB_SPIN_CAP) { atomicAdd(&bar[XB_TMO], 1u); break; } }
    }
    nloc = mine > 0u ? mine : 1u; nx = cnt > 0u ? cnt : 1u;
}
__device__ __forceinline__ void xcd_barrier(const XcdBarrier& b) {
    asm volatile("s_waitcnt vmcnt(0)" ::: "memory");
    __syncthreads();
    if (threadIdx.x == 0) {
        unsigned* bar = b.bar;
        __builtin_amdgcn_s_waitcnt(0);
        unsigned nloc = b.st[0], nx = b.st[1];
        if (nloc == 0u) { xcd_barrier_complete(bar, b.x, nloc, nx); b.st[0] = nloc; b.st[1] = nx; }
        const unsigned old = xb_add(&bar[XB_XSUB(b.x)], 1u);
        const unsigned gen = old / nloc;
        if (old + 1u == (gen + 1u) * nloc) {
            __builtin_amdgcn_fence(__ATOMIC_RELEASE, "agent");
            asm volatile("s_waitcnt vmcnt(0)" ::: "memory");
            const unsigned og = xb_add(&bar[XB_TOP], 1u);
            const unsigned tg = og / nx;
            if (og + 1u == (tg + 1u) * nx) xb_add(&bar[XB_TOPGEN], 1u);
            else XB_SPIN(xb_ld(&bar[XB_TOPGEN]) == tg, bar);
            __builtin_amdgcn_fence(__ATOMIC_ACQUIRE, "agent");
            xb_add(&bar[XB_XGEN(b.x)], 1u);
            asm volatile("s_waitcnt vmcnt(0)" ::: "memory");
        } else {
            XB_SPIN(xb_ld(&bar[XB_XGEN(b.x)]) == gen, bar);
            __builtin_amdgcn_fence(__ATOMIC_ACQUIRE, "agent");
            asm volatile("s_waitcnt vmcnt(0)" ::: "memory");
        }
    }
    __syncthreads();
}

struct Args { const float* in[23]; float* out; unsigned char* ws; int ph_lo, ph_hi; };
struct Frame {
    LAS unsigned char* lds;
    int tid, lane, wave, G;
};
template <int K, int NW, bool GAIN> __device__ __forceinline__ void quant_slab(const float* W, int N, const float* gain, signed char* WT, unsigned* cm, const Frame& F) {
    constexpr int RPW = 64 / NW, RSTEP = 8 * RPW, NV = K / RSTEP, RS = K + 4;
    constexpr bool PACK = NV > 128;
    static_assert(K % (4 * RSTEP) == 0 && NV % 4 == 0 && (NW * K / 16) % 512 == 0 && NW * RS + 1024 <= LDSCTL_OFF, "slab geometry");
    const int lane = F.lane, n = lane % NW, rq = lane / NW, w = F.wave;
    LAS unsigned char* T8 = (LAS unsigned char*)F.lds; LAS float* red = (LAS float*)(F.lds + NW * RS);
    const __amdgpu_buffer_rsrc_t rs = __builtin_amdgcn_make_buffer_rsrc((void*)W, 0, 0x7ffffff0, 0x00020000);
    const int kb = 4 * (RPW * w + rq);
    const unsigned vo = (unsigned)((kb * N + n) * 4);
#define SLAB_K(s) (4 * RSTEP * ((s) >> 2) + ((s) & 3))
#define SLAB_SO(s) ((unsigned)(SLAB_K(s) * N * 4))
    float m = 0.f;
    if constexpr (!PACK) {
        float v[NV];
#pragma unroll
        for (int s = 0; s < NV; ++s) v[s] = __builtin_bit_cast(float, __builtin_amdgcn_raw_buffer_load_b32(rs, vo, SLAB_SO(s), 0));
        if constexpr (GAIN) {
#pragma unroll
            for (int s = 0; s < NV; ++s) v[s] *= gain[SLAB_K(s) + kb]; }
#pragma unroll
        for (int s = 0; s < NV; ++s) m = fmaxf(m, fabsf(v[s]));
#pragma unroll
        for (int o = NW; o < 64; o <<= 1) m = fmaxf(m, __shfl_xor(m, o));
        if (rq == 0) red[w * NW + n] = m;
        __syncthreads();
#pragma unroll
        for (int i = 0; i < 8; ++i) m = fmaxf(m, red[i * NW + n]);
        if (w == 0 && rq == 0) cm[n] = __float_as_uint(m);
        const float inv = 127.f / fmaxf(m, 1e-30f);
#pragma unroll
        for (int s = 0; s < NV; s += 4) { const int a0 = (int)__builtin_rintf(v[s] * inv), a1 = (int)__builtin_rintf(v[s + 1] * inv), a2 = (int)__builtin_rintf(v[s + 2] * inv), a3 = (int)__builtin_rintf(v[s + 3] * inv);
            *(LAS unsigned*)(T8 + n * RS + SLAB_K(s) + kb) = ((unsigned)a0 & 255u) | (((unsigned)a1 & 255u) << 8) | (((unsigned)a2 & 255u) << 16) | ((unsigned)a3 << 24);
            if ((s & 28) == 28) __builtin_amdgcn_sched_barrier(0); }
    } else {
        unsigned pk[NV / 2];
        constexpr int BATCH = 16;
        static_assert(NV % BATCH == 0, "slab batch");
#pragma unroll
        for (int s0 = 0; s0 < NV; s0 += BATCH) { float x[BATCH];
#pragma unroll
            for (int i = 0; i < BATCH; ++i) x[i] = __builtin_bit_cast(float, __builtin_amdgcn_raw_buffer_load_b32(rs, vo, SLAB_SO(s0 + i), 0));
            if constexpr (GAIN) {
#pragma unroll
                for (int i = 0; i < BATCH; ++i) x[i] *= gain[SLAB_K(s0 + i) + kb]; }
#pragma unroll
            for (int i = 0; i < BATCH; i += 2) { m = fmaxf(m, fmaxf(fabsf(x[i]), fabsf(x[i + 1]))); unsigned p_ = pk2(x[i], x[i + 1]); asm volatile("" : "+v"(p_)); pk[(s0 + i) / 2] = p_; }
            asm volatile("" ::: "memory"); __builtin_amdgcn_sched_barrier(0); }
#pragma unroll
        for (int o = NW; o < 64; o <<= 1) m = fmaxf(m, __shfl_xor(m, o));
        if (rq == 0) red[w * NW + n] = m;
        __syncthreads();
#pragma unroll
        for (int i = 0; i < 8; ++i) m = fmaxf(m, red[i * NW + n]);
        if (w == 0 && rq == 0) cm[n] = __float_as_uint(m);
        const float inv = 127.f / fmaxf(m, 1e-30f);
#pragma unroll
        for (int s = 0; s < NV; s += 4) { const int a0 = (int)__builtin_rintf(bflo(pk[s / 2]) * inv), a1 = (int)__builtin_rintf(bfhi(pk[s / 2]) * inv), a2 = (int)__builtin_rintf(bflo(pk[s / 2 + 1]) * inv), a3 = (int)__builtin_rintf(bfhi(pk[s / 2 + 1]) * inv);
            *(LAS unsigned*)(T8 + n * RS + SLAB_K(s) + kb) = ((unsigned)a0 & 255u) | (((unsigned)a1 & 255u) << 8) | (((unsigned)a2 & 255u) << 16) | ((unsigned)a3 << 24);
            if ((s & 28) == 28) __builtin_amdgcn_sched_barrier(0); }
    }
#undef SLAB_K
#undef SLAB_SO
    __syncthreads();
#pragma unroll
    for (int j = 0; j < NW * K / 16 / 512; ++j) { const int ci = F.tid + 512 * j, nn = ci / (K / 16), c = ci % (K / 16);
        const LAS unsigned* src = (const LAS unsigned*)(T8 + nn * RS + 16 * c); v4u o; o.x = src[0]; o.y = src[1]; o.z = src[2]; o.w = src[3];
        *(GAS v4u*)(WT + (size_t)nn * K + 16 * c) = o;
        if ((j & 3) == 3) __builtin_amdgcn_sched_barrier(0); }
    __syncthreads();
}
__device__ __forceinline__ void wht_panel(const float* W, const float* gain, float* O, const Frame& F) {
    LAS float* L = (LAS float*)F.lds;
    const int t = F.tid, c4 = t & 7, r0 = t >> 3;
#pragma unroll
    for (int j = 0; j < 8; ++j) { const int k = r0 + 64 * j; const f32x4 v = *(const GAS f32x4*)(W + (size_t)k * D + 4 * c4) * gain[k]; LAS float* p = L + k * 33 + 4 * c4; p[0] = v.x; p[1] = v.y; p[2] = v.z; p[3] = v.w; }
    __syncthreads();
    const int col = t & 31, kq = t >> 5;
#pragma unroll 1
    for (int b = 0; b < 9; ++b) { const int bit = 1 << b;
        const int m = (b == 5) ? 56 : (b == 6) ? 120 : bit;
#pragma unroll 8
        for (int j = 0; j < 16; ++j) { const int idx = j * 16 + kq, k = ((idx >> b) << (b + 1)) | (idx & (bit - 1)); LAS float* p0 = L + k * 33 + col; LAS float* p1 = L + (k ^ m) * 33 + col; const float a = *p0, c = *p1; *p0 = a + c; *p1 = a - c; }
        __syncthreads(); }
#pragma unroll
    for (int j = 0; j < 8; ++j) { const int k = r0 + 64 * j; const LAS float* p = L + k * 33 + 4 * c4; *(GAS f32x4*)(O + (size_t)k * D + 4 * c4) = (f32x4){p[0], p[1], p[2], p[3]} * 0.04419417382415922f; }
    __syncthreads();
}
constexpr int S_GU = 176, S_EGU = 88, NSLAB_GU = 2 * S_GU + 16 * S_EGU;
constexpr int S_ED = 64, S_DD = 128, S_IN = 120, S_OUT = 64, NSLAB = 8 * S_ED + S_DD + 2 * S_IN + 2 * S_OUT + NSLAB_GU;
__device__ __forceinline__ void rowquant_phase(const Args& A, const Frame& F, const float* xa);
__device__ __forceinline__ void p0_prologue(const Args& A, const Frame& F) {
    unsigned char* ws = A.ws; unsigned* cm = (unsigned*)(ws + WS_CMAX);
    { float* wof = (float*)(ws + WS_WOF);
#pragma unroll 1
      for (int q = blockIdx.x; q < 2 * 2 * 64; q += F.G) { const int l = q >> 7, g = (q >> 6) & 1, n0 = 32 * (q & 63), kb = 1024 + 512 * g;
          wht_panel(A.in[13] + (size_t)l * D * D + (size_t)kb * D + n0, A.in[12] + l * D + kb, wof + (size_t)l * D * D + (size_t)kb * D + n0, F); }
      for (int o = blockIdx.x * 512 + F.tid; o < 2 * 1024 * (D / 4); o += F.G * 512) { const int l = o / (1024 * (D / 4)), r = o % (1024 * (D / 4)), k = r / (D / 4), c = r % (D / 4);
          *(GAS f32x4*)(wof + (size_t)l * D * D + (size_t)k * D + 4 * c) = *(const GAS f32x4*)(A.in[13] + (size_t)l * D * D + (size_t)k * D + 4 * c) * A.in[12][l * D + k]; } }
#pragma unroll 1
    for (int q = blockIdx.x; q < 8 * S_ED; q += F.G) { const int e = q / S_ED, n0 = 32 * (q % S_ED);
        quant_slab<2816, 32, false>(A.in[21] + (size_t)e * DE * D + n0, D, nullptr, (signed char*)(ws + WS_ED) + (size_t)e * D * DE + (size_t)n0 * DE, cm + CM_ED + e * D + n0, F); }
#pragma unroll 1
    for (int q = blockIdx.x; q < S_DD; q += F.G) { const int n0 = 16 * q;
        quant_slab<5632, 16, false>(A.in[17] + n0, D, nullptr, (signed char*)(ws + WS_WD) + (size_t)n0 * DFF, cm + CM_D + n0, F); }
#pragma unroll 1
    for (int q = (blockIdx.x + F.G - (S_DD % F.G)) % F.G; q < (2 * S_IN + NSLAB_GU) / 2; q += F.G) {
        const float* src; int N; const float* gain; signed char* dst; unsigned* cmb;
        if (q < S_IN) { const int l = q / (S_IN / 2), n0 = 64 * (q % (S_IN / 2)); src = A.in[2] + (size_t)l * D * DIN + n0; N = DIN; gain = A.in[1] + l * D; dst = (signed char*)(ws + WS_WIN) + (size_t)l * DIN * D + (size_t)n0 * D; cmb = cm + CM_IN + l * DIN + n0; }
        else { const int q3 = q - S_IN; int il, sl; const float* s0; signed char* d0; unsigned* c0;
            if (q3 < S_GU) { const int w_ = q3 / (S_GU / 2); s0 = A.in[15 + w_]; N = DFF; gain = A.in[14]; il = w_; c0 = cm + CM_GU; d0 = (signed char*)(ws + WS_WGU); sl = q3 % (S_GU / 2); }
            else { const int r2 = q3 - S_GU, w_ = r2 / (8 * (S_EGU / 2)), e_ = (r2 / (S_EGU / 2)) % 8; s0 = A.in[19 + w_] + (size_t)e_ * D * DE; N = DE; gain = A.in[14] + D; il = w_; c0 = cm + CM_EGU + e_ * 2 * DE; d0 = (signed char*)(ws + WS_EGU) + (size_t)e_ * 2 * DE * D; sl = r2 % (S_EGU / 2); }
            const int n0 = 64 * sl, drow0 = 256 * (n0 >> 7) + 128 * il + (n0 & 127); src = s0 + n0; dst = d0 + (size_t)drow0 * D; cmb = c0 + drow0; }
        quant_slab<2048, 64, true>(src, N, gain, dst, cmb, F);
    }
    for (int o = blockIdx.x * 512 + F.tid; o < 2 * 8 * 64 * 64; o += F.G * 512) { const int i = o & 63, j = (o >> 6) & 63, lh = o >> 12; const size_t src = ((size_t)lh * 64 + i) * 64 + j;
        ((bf16*)(ws + WS_WAT))[o] = (bf16)f2bf(A.in[7][src]); ((bf16*)(ws + WS_WXT))[o] = (bf16)f2bf(A.in[9][src]); }
    for (int o = blockIdx.x * 512 + F.tid; o < D * 8; o += F.G * 512) { const int k = o >> 3, e = o & 7; const float v = A.in[18][o] * A.in[14][D + k];
        const unsigned hi_ = f2bf(v); const float r_ = v - __builtin_bit_cast(float, hi_ << 16); ((bf16*)(ws + WS_RWT))[e * D + k] = (bf16)hi_; ((bf16*)(ws + WS_RWT))[8 * D + e * D + k] = (bf16)f2bf(r_); }
    rowquant_phase(A, F, A.in[0]);
}
__device__ __forceinline__ void rowquant_phase(const Args& A, const Frame& F, const float* xa) {
    const int gw = blockIdx.x * NWAVES + F.wave, NGW = F.G * NWAVES, lane = F.lane;
    signed char* xq = (signed char*)(A.ws + WS_XQ8); float* as = (float*)(A.ws + WS_AS);
    for (int m = gw; m < T; m += NGW) {
        const GAS f32x4* xr = (const GAS f32x4*)(xa + (size_t)m * D) + lane; f32x4 v[8]; float q = 0.f, mx = 0.f;
#pragma unroll
        for (int j = 0; j < 8; ++j) { v[j] = xr[64 * j]; q += (v[j].x * v[j].x + v[j].y * v[j].y) + (v[j].z * v[j].z + v[j].w * v[j].w);
            mx = fmaxf(fmaxf(mx, fmaxf(fabsf(v[j].x), fabsf(v[j].y))), fmaxf(fabsf(v[j].z), fabsf(v[j].w))); }
        q = wave_sum(q);
#pragma unroll
        for (int o = 1; o < 64; o <<= 1) mx = fmaxf(mx, __shfl_xor(mx, o));
        mx = fmaxf(mx, 1e-30f); const float inv = 127.f / mx;
        GAS unsigned* o4 = (GAS unsigned*)(xq + (size_t)m * D) + lane;
#pragma unroll
        for (int j = 0; j < 8; ++j) { const int a0 = (int)__builtin_rintf(v[j].x * inv), a1 = (int)__builtin_rintf(v[j].y * inv), a2 = (int)__builtin_rintf(v[j].z * inv), a3 = (int)__builtin_rintf(v[j].w * inv);
            o4[64 * j] = ((unsigned)a0 & 255u) | (((unsigned)a1 & 255u) << 8) | (((unsigned)a2 & 255u) << 16) | ((unsigned)a3 << 24); }
        if (lane == 0) as[m] = mx * (1.f / 127.f) * rsqrtf(q * (1.f / D) + EPS);
    }
}

template <int NCOL, int VEC> __device__ __forceinline__ void actquant_phase(const Frame& F, const bf16* src, signed char* dst, float* sc, const float* gws, int nrows) {
    constexpr int CH = NCOL / VEC / 64, NW32 = VEC / 2;
    static_assert(NCOL % (VEC * 64) == 0, "act row geometry");
    const int gw = blockIdx.x * NWAVES + F.wave, NGW = F.G * NWAVES, lane = F.lane;
    for (int m = gw; m < nrows; m += NGW) {
        unsigned w[CH][NW32]; float mx = 0.f;
#pragma unroll
        for (int j = 0; j < CH; ++j) {
            if constexpr (VEC == 8) { const v4u r = ((const GAS v4u*)(src + (size_t)m * NCOL))[lane + 64 * j]; w[j][0] = r.x; w[j][1] = r.y; w[j][2] = r.z; w[j][3] = r.w; }
            else { const v2u r = ((const GAS v2u*)(src + (size_t)m * NCOL))[lane + 64 * j]; w[j][0] = r.x; w[j][1] = r.y; }
#pragma unroll
            for (int i = 0; i < NW32; ++i) mx = fmaxf(mx, fmaxf(fabsf(bflo(w[j][i])), fabsf(bfhi(w[j][i])))); }
#pragma unroll
        for (int o = 1; o < 64; o <<= 1) mx = fmaxf(mx, __shfl_xor(mx, o));
        mx = fmaxf(mx, 1e-30f); const float inv = 127.f / mx;
#pragma unroll
        for (int j = 0; j < CH; ++j) { unsigned o[NW32 / 2];
#pragma unroll
            for (int i = 0; i < NW32 / 2; ++i) { const int a0 = (int)__builtin_rintf(bflo(w[j][2 * i]) * inv), a1 = (int)__builtin_rintf(bfhi(w[j][2 * i]) * inv), a2 = (int)__builtin_rintf(bflo(w[j][2 * i + 1]) * inv), a3 = (int)__builtin_rintf(bfhi(w[j][2 * i + 1]) * inv);
                o[i] = ((unsigned)a0 & 255u) | (((unsigned)a1 & 255u) << 8) | (((unsigned)a2 & 255u) << 16) | ((unsigned)a3 << 24); }
            if constexpr (VEC == 8) { v2u ov; ov.x = o[0]; ov.y = o[1]; ((GAS v2u*)(dst + (size_t)m * NCOL))[lane + 64 * j] = ov; }
            else ((GAS unsigned*)(dst + (size_t)m * NCOL))[lane + 64 * j] = o[0]; }
        if (lane == 0) sc[m] = mx * (1.f / 127.f) * (gws ? gws[m] : 1.f);
    }
}

__device__ __forceinline__ void rowquant16_phase(const Args& A, const Frame& F, const bf16* xa) {
    const int gw = blockIdx.x * NWAVES + F.wave, NGW = F.G * NWAVES, lane = F.lane;
    signed char* xq = (signed char*)(A.ws + WS_XQ8); float* as = (float*)(A.ws + WS_AS);
    for (int m0 = gw; m0 < T; m0 += 2 * NGW) {
        const int m1 = (m0 + NGW < T) ? m0 + NGW : m0;
        v4u v[2][4];
#pragma unroll
        for (int r = 0; r < 2; ++r) { const GAS v4u* xr = (const GAS v4u*)(xa + (size_t)(r ? m1 : m0) * D) + lane;
#pragma unroll
            for (int j = 0; j < 4; ++j) v[r][j] = xr[64 * j]; }
#pragma unroll
        for (int r = 0; r < 2; ++r) { const int m = r ? m1 : m0; float q = 0.f, mx = 0.f;
#pragma unroll
            for (int j = 0; j < 4; ++j) { const unsigned ww[4] = {v[r][j].x, v[r][j].y, v[r][j].z, v[r][j].w};
#pragma unroll
                for (int i = 0; i < 4; ++i) { const float a = bflo(ww[i]), b = bfhi(ww[i]); q += a * a + b * b; mx = fmaxf(mx, fmaxf(fabsf(a), fabsf(b))); } }
            q = wave_sum(q);
#pragma unroll
            for (int o = 1; o < 64; o <<= 1) mx = fmaxf(mx, __shfl_xor(mx, o));
            mx = fmaxf(mx, 1e-30f); const float inv = 127.f / mx;
            GAS v2u* o8 = (GAS v2u*)(xq + (size_t)m * D) + lane;
#pragma unroll
            for (int j = 0; j < 4; ++j) { const unsigned ww[4] = {v[r][j].x, v[r][j].y, v[r][j].z, v[r][j].w}; unsigned o[2];
#pragma unroll
                for (int i = 0; i < 2; ++i) { const int a0 = (int)__builtin_rintf(bflo(ww[2 * i]) * inv), a1 = (int)__builtin_rintf(bfhi(ww[2 * i]) * inv), a2 = (int)__builtin_rintf(bflo(ww[2 * i + 1]) * inv), a3 = (int)__builtin_rintf(bfhi(ww[2 * i + 1]) * inv);
                    o[i] = ((unsigned)a0 & 255u) | (((unsigned)a1 & 255u) << 8) | (((unsigned)a2 & 255u) << 16) | ((unsigned)a3 << 24); }
                o8[64 * j] = (v2u){o[0], o[1]}; }
            if (lane == 0) as[m] = mx * (1.f / 127.f) * rsqrtf(q * (1.f / D) + EPS); }
    }
}

__device__ __forceinline__ void wout_quant(const Args& A, const Frame& F) {
    unsigned char* ws = A.ws;
#pragma unroll 1
    for (int q = (int)((blockIdx.x + 64) % F.G); q < 64; q += F.G) { const int l = q >> 5, n0 = 64 * (q & 31);
        quant_slab<2048, 64, false>((const float*)(ws + WS_WOF) + (size_t)l * D * D + n0, D, nullptr, (signed char*)(ws + WS_WOUT) + (size_t)l * D * D + (size_t)n0 * D, (unsigned*)(ws + WS_CMAX) + CM_OUT + l * D + n0, F); }
}
__device__ __forceinline__ void attn_unit(const Frame& F, int unit, const bf16* proj, bf16* amix, float* ssqa, const float* sinks) {
    const int b = unit >> 6, nb = (unit >> 1) & 31, kvh = unit & 1;
    const int tok0 = b * SEQ + nb * 128;
    LAS bf16* Ks = (LAS bf16*)(F.lds);
    LAS bf16* Vt = (LAS bf16*)(F.lds + 36864);
#pragma unroll
    for (int i = F.tid; i < 2048; i += 512) {
        const int kw = i >> 3, c = i & 7; const bool valid = (nb > 0) || (kw >= 128);
        v4u kv = {0u, 0u, 0u, 0u}, vv = {0u, 0u, 0u, 0u};
        if (valid) { const bf16* rp = proj + (size_t)(tok0 - 128 + kw) * DIN; kv = *(const GAS v4u*)(rp + C_K + kvh * 64 + c * 8); vv = *(const GAS v4u*)(rp + C_V + kvh * 64 + c * 8); }
        *(LAS v4u*)(Ks + kw * 72 + c * 8) = kv;
        LAS bf16* vp = Vt + (c * 8) * 264 + kw;
        vp[0 * 264] = (bf16)(vv.x & 0xffffu); vp[1 * 264] = (bf16)(vv.x >> 16); vp[2 * 264] = (bf16)(vv.y & 0xffffu); vp[3 * 264] = (bf16)(vv.y >> 16);
        vp[4 * 264] = (bf16)(vv.z & 0xffffu); vp[5 * 264] = (bf16)(vv.z >> 16); vp[6 * 264] = (bf16)(vv.w & 0xffffu); vp[7 * 264] = (bf16)(vv.w >> 16);
    }
    __syncthreads();
    const int h = kvh * 8 + F.wave, lane = F.lane, ql = lane & 31, hi = lane >> 5;
    const float sink2 = sinks[h] * LOG2E; const float SC = 0.125f * LOG2E; const float NEG = -__builtin_inff();
    bf16x8 qf[4], qn[4];
#pragma unroll
    for (int ks = 0; ks < 4; ++ks) { qf[ks] = *(const GAS bf16x8*)(proj + ((size_t)tok0 + ql) * DIN + C_Q + h * 64 + 16 * ks + 8 * hi); qn[ks] = qf[ks]; }
#pragma unroll 1
    for (int qs = 0; qs < 128; qs += 32) {
        const size_t tq = (size_t)tok0 + qs + ql;
        if (qs + 32 < 128) {
#pragma unroll
            for (int ks = 0; ks < 4; ++ks) qn[ks] = *(const GAS bf16x8*)(proj + (tq + 32) * DIN + C_Q + h * 64 + 16 * ks + 8 * hi); }
        f32x16 s[5];
#pragma unroll
        for (int kt = 0; kt < 5; ++kt) { f32x16 a = {};
#pragma unroll
            for (int ks = 0; ks < 4; ++ks) { const bf16x8 kf = *(const LAS bf16x8*)(Ks + (qs + 32 * kt + ql) * 72 + 16 * ks + 8 * hi); a = MFMA32(kf, qf[ks], a); }
            s[kt] = a; }
#pragma unroll
        for (int i = 0; i < 16; ++i) { const int kk = (i & 3) + 8 * (i >> 2) + 4 * hi; s[0][i] = (kk > ql) ? s[0][i] : NEG; s[4][i] = (kk <= ql) ? s[4][i] : NEG; }
        if (nb == 0) {
#pragma unroll
            for (int kt = 0; kt < 5; ++kt)
#pragma unroll
                for (int i = 0; i < 16; ++i) { const int kw = qs + 32 * kt + (i & 3) + 8 * (i >> 2) + 4 * hi; s[kt][i] = (kw >= 128) ? s[kt][i] : NEG; } }
        float mr = NEG;
#pragma unroll
        for (int kt = 0; kt < 5; ++kt)
#pragma unroll
            for (int i = 0; i < 16; i += 2) mr = fmaxf(fmaxf(mr, s[kt][i]), s[kt][i + 1]);
        mr = fmaxf(mr, __shfl_xor(mr, 32));
        const float mx = fmaxf(mr * SC, sink2);
        float sum = 0.f;
#pragma unroll
        for (int kt = 0; kt < 5; ++kt)
#pragma unroll
            for (int i = 0; i < 16; ++i) { const float p = __builtin_amdgcn_exp2f(__builtin_fmaf(s[kt][i], SC, -mx)); s[kt][i] = p; sum += p; }
        sum += __shfl_xor(sum, 32);
        const float inv = 1.f / (sum + __builtin_amdgcn_exp2f(sink2 - mx));
        f32x16 o[2]; o[0] = (f32x16){}; o[1] = (f32x16){};
#pragma unroll
        for (int kt = 0; kt < 5; ++kt)
#pragma unroll
            for (int st = 0; st < 2; ++st) {
                v4u pw; pw.x = pk2(s[kt][8 * st + 0], s[kt][8 * st + 1]); pw.y = pk2(s[kt][8 * st + 2], s[kt][8 * st + 3]); pw.z = pk2(s[kt][8 * st + 4], s[kt][8 * st + 5]); pw.w = pk2(s[kt][8 * st + 6], s[kt][8 * st + 7]);
                const bf16x8 pf = __builtin_bit_cast(bf16x8, pw);
                const int kbase = qs + 32 * kt + 16 * st + 4 * hi;
#pragma unroll
                for (int dt = 0; dt < 2; ++dt) { const LAS bf16* vp = Vt + (dt * 32 + ql) * 264 + kbase; const v2u lo = *(const LAS v2u*)vp, hi8 = *(const LAS v2u*)(vp + 8);
                    v4u vw; vw.x = lo.x; vw.y = lo.y; vw.z = hi8.x; vw.w = hi8.y; o[dt] = MFMA32(__builtin_bit_cast(bf16x8, vw), pf, o[dt]); }
            }
        float q = 0.f;
#pragma unroll
        for (int dt = 0; dt < 2; ++dt)
#pragma unroll
            for (int g4 = 0; g4 < 4; ++g4) { const float v0 = o[dt][4 * g4] * inv, v1 = o[dt][4 * g4 + 1] * inv, v2 = o[dt][4 * g4 + 2] * inv, v3 = o[dt][4 * g4 + 3] * inv;
                q += (v0 * v0 + v1 * v1) + (v2 * v2 + v3 * v3); v2u w; w.x = pk2(v0, v1); w.y = pk2(v2, v3);
                *(GAS v2u*)(amix + tq * 1024 + h * 64 + dt * 32 + 8 * g4 + 4 * hi) = w; }
        q += __shfl_xor(q, 32);
        if (hi == 0) ssqa[tq * 16 + h] = q;
#pragma unroll
        for (int ks = 0; ks < 4; ++ks) qf[ks] = qn[ks];
    }
    __syncthreads();
}

__device__ __forceinline__ float gelu_tanh(float x) { const float z = 0.7978845608028654f * (x + 0.044715f * x * x * x); return x * sigmoidf_(2.f * z); }
template <bool FULL> __device__ __forceinline__ void lru_chunk(const Args& A, const Frame& F, int unit, int layer, const bf16* proj, float2* lsum, float (&y)[64], bf16* hl = nullptr, bf16* pl = nullptr) {
    const int b = unit >> 6, c64 = unit & 63, hh = F.wave, lane = F.lane, tl = lane & 31, hi = lane >> 5;
    const int ch0 = hh * 64, s0 = c64 * 64; const size_t t0 = (size_t)b * SEQ + s0;
    LAS float* XA = (LAS float*)(F.lds + hh * LRU_WREG); LAS float* U = XA + 32 * 68;
    const float* cw = A.in[5] + layer * 4 * 512; const float* cbias = A.in[6] + layer * 512;
    const float* ba = A.in[8] + layer * 512; const float* bx = A.in[10] + layer * 512; const float* lam = A.in[11] + layer * 512;
    const bf16* wat = (const bf16*)(A.ws + WS_WAT) + (size_t)(layer * 8 + hh) * 4096; const bf16* wxt = (const bf16*)(A.ws + WS_WXT) + (size_t)(layer * 8 + hh) * 4096;
    float nba0 = 0.f, nba1 = 0.f, nbx0 = 0.f, nbx1 = 0.f, sp0 = 0.f, sp1 = 0.f;
    if constexpr (!FULL) { nba0 = -LOG2E * ba[ch0 + tl]; nba1 = -LOG2E * ba[ch0 + 32 + tl]; nbx0 = -LOG2E * bx[ch0 + tl]; nbx1 = -LOG2E * bx[ch0 + 32 + tl];
        sp0 = -8.f * LOG2E * log1pf(__expf(-lam[ch0 + tl])); sp1 = -8.f * LOG2E * log1pf(__expf(-lam[ch0 + 32 + tl])); }
    float h = 0.f, P = 1.f;
    if (FULL) { const float2* lp = lsum + (size_t)(b * 64) * 512 + ch0 + lane;
#pragma unroll 1
        for (int j0 = 0; j0 < c64; j0 += 16) { float2 sm[16];
#pragma unroll
            for (int i = 0; i < 16; ++i) sm[i] = (j0 + i < c64) ? lp[(size_t)(j0 + i) * 512] : make_float2(1.f, 0.f);
#pragma unroll
            for (int i = 0; i < 16; ++i) h = sm[i].x * h + sm[i].y; } }
#pragma unroll
    for (int tt = 0; tt < 2; ++tt) {
        { LAS unsigned char* LX = (LAS unsigned char*)U;
          LAS float* CW = (LAS float*)(LX + 35 * 144);
#pragma unroll
          for (int it = 0; it < 5; ++it) { const int i = lane + 64 * it; if (i < 35 * 8) { const int row = i >> 3, c = i & 7; const int sp = s0 + 32 * tt - 3 + row;
                v4u v = {0u, 0u, 0u, 0u}; if (sp >= 0) v = *(const GAS v4u*)(proj + (t0 + 32 * tt - 3 + row) * DIN + C_LX + ch0 + 8 * c);
                *(LAS v4u*)(LX + row * 144 + 16 * c) = v; } }
#pragma unroll
          for (int k = 0; k < 4; ++k) CW[k * 64 + lane] = cw[k * 512 + ch0 + lane];
          CW[4 * 64 + lane] = cbias[ch0 + lane];
          LDS_WAIT();
#pragma unroll 1
          for (int ks = 0; ks < 4; ++ks) { const int cb8 = 16 * ks + 8 * hi;
            float a8[8];
            { const f32x4 b0 = *(const LAS f32x4*)(CW + 4 * 64 + cb8), b1 = *(const LAS f32x4*)(CW + 4 * 64 + cb8 + 4); a8[0] = b0.x; a8[1] = b0.y; a8[2] = b0.z; a8[3] = b0.w; a8[4] = b1.x; a8[5] = b1.y; a8[6] = b1.z; a8[7] = b1.w; }
#pragma unroll
            for (int k = 0; k < 4; ++k) { const v4u raw = *(const LAS v4u*)(LX + (tl + 3 - k) * 144 + 2 * cb8);
                const f32x4 w0 = *(const LAS f32x4*)(CW + k * 64 + cb8), w1 = *(const LAS f32x4*)(CW + k * 64 + cb8 + 4);
                a8[0] += w0.x * bflo(raw.x); a8[1] += w0.y * bfhi(raw.x); a8[2] += w0.z * bflo(raw.y); a8[3] += w0.w * bfhi(raw.y);
                a8[4] += w1.x * bflo(raw.z); a8[5] += w1.y * bfhi(raw.z); a8[6] += w1.z * bflo(raw.w); a8[7] += w1.w * bfhi(raw.w); }
            LAS float* xp = XA + tl * 68 + cb8;
            *(LAS f32x4*)xp = (f32x4){a8[0], a8[1], a8[2], a8[3]}; *(LAS f32x4*)(xp + 4) = (f32x4){a8[4], a8[5], a8[6], a8[7]}; } }
        LDS_WAIT();
        bf16x8 af[4];
#pragma unroll
        for (int ks = 0; ks < 4; ++ks) { const LAS float* xp = XA + tl * 68 + 16 * ks + 8 * hi; const f32x4 x0 = *(const LAS f32x4*)xp, x1 = *(const LAS f32x4*)(xp + 4);
            v4u pw; pw.x = pk2(x0.x, x0.y); pw.y = pk2(x0.z, x0.w); pw.z = pk2(x1.x, x1.y); pw.w = pk2(x1.z, x1.w); af[ks] = __builtin_bit_cast(bf16x8, pw); }
        LDS_WAIT();
#pragma unroll 1
        for (int jt = 0; jt < 2; ++jt) { const int j = 32 * jt + tl; f32x16 ra = {}, ia = {};
#pragma unroll
            for (int ks = 0; ks < 4; ++ks) { const bf16x8 bw = *(const GAS bf16x8*)(wat + j * 64 + 16 * ks + 8 * hi), bv = *(const GAS bf16x8*)(wxt + j * 64 + 16 * ks + 8 * hi);
                ra = MFMA32(af[ks], bw, ra); ia = MFMA32(af[ks], bv, ia); }
            float nba_j, nbx_j, sp_j;
            if constexpr (FULL) { nba_j = -LOG2E * ba[ch0 + j]; nbx_j = -LOG2E * bx[ch0 + j]; sp_j = -8.f * LOG2E * log1pf(__expf(-lam[ch0 + j])); }
            else { nba_j = jt ? nba1 : nba0; nbx_j = jt ? nbx1 : nbx0; sp_j = jt ? sp1 : sp0; }
#pragma unroll
            for (int r = 0; r < 16; ++r) { const int tok = (r & 3) + 8 * (r >> 2) + 4 * hi; const float xcv = XA[tok * 68 + j];
                const float rr = __builtin_amdgcn_rcpf(1.f + __builtin_amdgcn_exp2f(__builtin_fmaf(ra[r], -LOG2E, nba_j))), ii = __builtin_amdgcn_rcpf(1.f + __builtin_amdgcn_exp2f(__builtin_fmaf(ia[r], -LOG2E, nbx_j)));
                const float a = __builtin_amdgcn_exp2f(rr * sp_j); const float u = __builtin_amdgcn_sqrtf(fmaxf(1.f - a * a, 0.f)) * ii * xcv;
                XA[tok * 68 + j] = a; U[tok * 68 + j] = u; } }
        LDS_WAIT();
#pragma unroll
        for (int t = 0; t < 32; ++t) { const float a = XA[t * 68 + lane], u = U[t * 68 + lane]; h = a * h + u; P *= a;
            if (FULL) { const float lgv = bf1(proj[(t0 + 32 * tt + t) * DIN + C_LG + ch0 + lane]); y[32 * tt + t] = h * gelu_tanh(lgv); }
            else { XA[t * 68 + lane] = h; U[t * 68 + lane] = P; } }
        LDS_WAIT();
        if constexpr (!FULL) {
#pragma unroll
            for (int j = 0; j < 4; ++j) { const int tok = (lane >> 3) + 8 * j, c8 = (lane & 7) * 8; const size_t o = (t0 + 32 * tt + tok) * 512 + ch0 + c8;
                const f32x4 h0 = *(const LAS f32x4*)(XA + tok * 68 + c8), h1 = *(const LAS f32x4*)(XA + tok * 68 + c8 + 4), q0 = *(const LAS f32x4*)(U + tok * 68 + c8), q1 = *(const LAS f32x4*)(U + tok * 68 + c8 + 4);
                *(GAS v4u*)(hl + o) = (v4u){pk2(h0.x, h0.y), pk2(h0.z, h0.w), pk2(h1.x, h1.y), pk2(h1.z, h1.w)};
                *(GAS v4u*)(pl + o) = (v4u){pk2(q0.x, q0.y), pk2(q0.z, q0.w), pk2(q1.x, q1.y), pk2(q1.z, q1.w)}; }
            LDS_WAIT(); }
    }
    if (!FULL) lsum[(size_t)(b * 64 + c64) * 512 + ch0 + lane] = make_float2(P, h);
}
template <int CTRL> __device__ __forceinline__ float dpp_get(float v) { return __builtin_bit_cast(float, __builtin_amdgcn_update_dpp(0, __builtin_bit_cast(int, v), CTRL, 0xF, 0xF, false)); }
__device__ __forceinline__ float wave_sum_all(float v) {
    v += dpp_get<0xB1>(v); v += dpp_get<0x4E>(v); v += dpp_get<0x141>(v); v += dpp_get<0x140>(v);
    { const auto rr = __builtin_amdgcn_permlane16_swap(__float_as_uint(v), __float_as_uint(v), false, false); v = __uint_as_float(rr[0]) + __uint_as_float(rr[1]); }
    { const auto rr = __builtin_amdgcn_permlane32_swap(__float_as_uint(v), __float_as_uint(v), false, false); v = __uint_as_float(rr[0]) + __uint_as_float(rr[1]); }
    return v;
}
__device__ __forceinline__ float wave_max_all(float v) {
    v = fmaxf(v, dpp_get<0xB1>(v)); v = fmaxf(v, dpp_get<0x4E>(v)); v = fmaxf(v, dpp_get<0x141>(v)); v = fmaxf(v, dpp_get<0x140>(v));
    { const auto rr = __builtin_amdgcn_permlane16_swap(__float_as_uint(v), __float_as_uint(v), false, false); v = fmaxf(__uint_as_float(rr[0]), __uint_as_float(rr[1])); }
    { const auto rr = __builtin_amdgcn_permlane32_swap(__float_as_uint(v), __float_as_uint(v), false, false); v = fmaxf(__uint_as_float(rr[0]), __uint_as_float(rr[1])); }
    return v;
}
__device__ __forceinline__ float row16_sum_all(float v) { v += dpp_get<0xB1>(v); v += dpp_get<0x4E>(v); v += dpp_get<0x141>(v); v += dpp_get<0x140>(v); return v; }
template <int CTRL> __device__ __forceinline__ void wht_dpp_stage(float (&v)[8], bool up) {
#pragma unroll
    for (int i = 0; i < 8; ++i) { const float p = dpp_get<CTRL>(v[i]); v[i] = up ? p - v[i] : v[i] + p; }
}
__device__ __forceinline__ void wht512(float (&v)[8], int lane) {
#pragma unroll
    for (int b = 0; b < 3; ++b)
#pragma unroll
        for (int i = 0; i < 8; ++i) if (!(i & (1 << b))) { const float a = v[i], c = v[i | (1 << b)]; v[i] = a + c; v[i | (1 << b)] = a - c; }
    wht_dpp_stage<0xB1>(v, lane & 1); wht_dpp_stage<0x4E>(v, lane & 2); wht_dpp_stage<0x141>(v, lane & 4); wht_dpp_stage<0x140>(v, lane & 8);
    { const float s16 = (lane & 16) ? -1.f : 1.f;
#pragma unroll
      for (int i = 0; i < 8; ++i) { const auto rr = __builtin_amdgcn_permlane16_swap(__float_as_uint(v[i]), __float_as_uint(v[i]), false, false); v[i] = __uint_as_float(rr[0]) + s16 * __uint_as_float(rr[1]); } }
    { const float s32 = (lane & 32) ? -0.04419417382415922f : 0.04419417382415922f;
#pragma unroll
      for (int i = 0; i < 8; ++i) { const auto rr = __builtin_amdgcn_permlane32_swap(__float_as_uint(v[i]), __float_as_uint(v[i]), false, false); v[i] = 0.04419417382415922f * __uint_as_float(rr[0]) + s32 * __uint_as_float(rr[1]); } }
}
__device__ __forceinline__ void mix_unit(const Args& A, const Frame& F, int unit, int layer, const bf16* proj, const bf16* amixb, signed char* amix8, float* asm_o, const float* ssqa, const float2* lsum, const bf16* hl, const bf16* pl) {
    const int b = unit >> 6, c64 = unit & 63, lane = F.lane, s0 = c64 * 64; const size_t t0 = (size_t)b * SEQ + s0;
    float carry[8];
#pragma unroll
    for (int j = 0; j < 8; ++j) carry[j] = 0.f;
    { const float2* lp = lsum + (size_t)(b * 64) * 512 + lane * 8;
#pragma unroll 1
      for (int j0 = 0; j0 < c64; j0 += 4) { f32x4 sm[4][4];
#pragma unroll
          for (int i = 0; i < 4; ++i)
#pragma unroll
              for (int q = 0; q < 4; ++q) sm[i][q] = (j0 + i < c64) ? *(const GAS f32x4*)((const float*)(lp + (size_t)(j0 + i) * 512) + 4 * q) : (f32x4){1.f, 0.f, 1.f, 0.f};
#pragma unroll
          for (int i = 0; i < 4; ++i)
#pragma unroll
              for (int q = 0; q < 4; ++q) { carry[2 * q] = sm[i][q].x * carry[2 * q] + sm[i][q].y; carry[2 * q + 1] = sm[i][q].z * carry[2 * q + 1] + sm[i][q].w; } } }
    const float* cwp = A.in[4] + layer * 3 * 512 + lane * 8;
    float w0[8], w1[8], w2[8];
    { const f32x4 a0 = *(const GAS f32x4*)(cwp), a1 = *(const GAS f32x4*)(cwp + 4), b0 = *(const GAS f32x4*)(cwp + 512), b1 = *(const GAS f32x4*)(cwp + 516), c0 = *(const GAS f32x4*)(cwp + 1024), c1 = *(const GAS f32x4*)(cwp + 1028);
      w0[0] = a0.x; w0[1] = a0.y; w0[2] = a0.z; w0[3] = a0.w; w0[4] = a1.x; w0[5] = a1.y; w0[6] = a1.z; w0[7] = a1.w;
      w1[0] = b0.x; w1[1] = b0.y; w1[2] = b0.z; w1[3] = b0.w; w1[4] = b1.x; w1[5] = b1.y; w1[6] = b1.z; w1[7] = b1.w;
      w2[0] = c0.x; w2[1] = c0.y; w2[2] = c0.z; w2[3] = c0.w; w2[4] = c1.x; w2[5] = c1.y; w2[6] = c1.z; w2[7] = c1.w; }
    float p0[8], p1[8], p2[8];
#pragma unroll
    for (int j = 0; j < 8; ++j) { p0[j] = 0.f; p1[j] = 0.f; p2[j] = 0.f; }
#pragma unroll 2
    for (int i = -2; i < 8; ++i) { const int tok = 8 * F.wave + i; const size_t t = t0 + tok;
#pragma unroll
        for (int j = 0; j < 8; ++j) { p2[j] = p1[j]; p1[j] = p0[j]; p0[j] = 0.f; }
        if (s0 + tok >= 0) { const bf16* rp = proj + t * DIN; const v4u cc = *(const GAS v4u*)(rp + C_CC + lane * 8), cx = *(const GAS v4u*)(rp + C_CX + lane * 8);
            p0[0] = bflo(cc.x) * bflo(cx.x); p0[1] = bfhi(cc.x) * bfhi(cx.x); p0[2] = bflo(cc.y) * bflo(cx.y); p0[3] = bfhi(cc.y) * bfhi(cx.y);
            p0[4] = bflo(cc.z) * bflo(cx.z); p0[5] = bfhi(cc.z) * bfhi(cx.z); p0[6] = bflo(cc.w) * bflo(cx.w); p0[7] = bfhi(cc.w) * bfhi(cx.w); }
        if (i >= 0) {
            const v4u cbv = *(const GAS v4u*)(proj + t * DIN + C_CB + lane * 8);
            float yc[8]; const float cbf[8] = {bflo(cbv.x), bfhi(cbv.x), bflo(cbv.y), bfhi(cbv.y), bflo(cbv.z), bfhi(cbv.z), bflo(cbv.w), bfhi(cbv.w)};
            float qc = 0.f;
#pragma unroll
            for (int j = 0; j < 8; ++j) { yc[j] = cbf[j] * (w0[j] * p0[j] + w1[j] * p1[j] + w2[j] * p2[j]); qc += yc[j] * yc[j]; }
            f32x4 y0, y1;
            { const v4u hv = *(const GAS v4u*)(hl + t * 512 + lane * 8), pv = *(const GAS v4u*)(pl + t * 512 + lane * 8), gv = *(const GAS v4u*)(proj + t * DIN + C_LG + lane * 8);
              y0.x = (bflo(hv.x) + bflo(pv.x) * carry[0]) * gelu_tanh(bflo(gv.x)); y0.y = (bfhi(hv.x) + bfhi(pv.x) * carry[1]) * gelu_tanh(bfhi(gv.x));
              y0.z = (bflo(hv.y) + bflo(pv.y) * carry[2]) * gelu_tanh(bflo(gv.y)); y0.w = (bfhi(hv.y) + bfhi(pv.y) * carry[3]) * gelu_tanh(bfhi(gv.y));
              y1.x = (bflo(hv.z) + bflo(pv.z) * carry[4]) * gelu_tanh(bflo(gv.z)); y1.y = (bfhi(hv.z) + bfhi(pv.z) * carry[5]) * gelu_tanh(bfhi(gv.z));
              y1.z = (bflo(hv.w) + bflo(pv.w) * carry[6]) * gelu_tanh(bflo(gv.w)); y1.w = (bfhi(hv.w) + bfhi(pv.w) * carry[7]) * gelu_tanh(bfhi(gv.w)); }
            float ql = (y0.x * y0.x + y0.y * y0.y) + (y0.z * y0.z + y0.w * y0.w) + (y1.x * y1.x + y1.y * y1.y) + (y1.z * y1.z + y1.w * y1.w);
            qc = wave_sum_all(qc); ql = wave_sum_all(ql);
            const float sa = row16_sum_all(ssqa[t * 16 + (lane & 15)]);
            const float ra_inv = sqrtf(sa * (1.f / 1024.f) + EPS);
            const float fc = rsqrtf(qc * (1.f / 512.f) + EPS) * ra_inv, fl = rsqrtf(ql * (1.f / 512.f) + EPS) * ra_inv;
            float yl[8] = {y0.x * fl, y0.y * fl, y0.z * fl, y0.w * fl, y1.x * fl, y1.y * fl, y1.z * fl, y1.w * fl};
#pragma unroll
            for (int j = 0; j < 8; ++j) yc[j] *= fc;
            wht512(yc, lane); wht512(yl, lane);
            const v4u at0 = *(const GAS v4u*)(amixb + t * 1024 + lane * 8), at1 = *(const GAS v4u*)(amixb + t * 1024 + 512 + lane * 8);
            const unsigned aw[8] = {at0.x, at0.y, at0.z, at0.w, at1.x, at1.y, at1.z, at1.w};
            float mx = 0.f;
#pragma unroll
            for (int j = 0; j < 8; ++j) { mx = fmaxf(mx, fmaxf(fabsf(yc[j]), fabsf(yl[j]))); mx = fmaxf(mx, fmaxf(fabsf(bflo(aw[j])), fabsf(bfhi(aw[j])))); }
            mx = wave_max_all(mx);
            mx = fmaxf(mx, 1e-30f); const float inv = 127.f / mx;
            unsigned qa[4], qc2[2], ql2[2];
#pragma unroll
            for (int j = 0; j < 4; ++j) { const int a0 = (int)__builtin_rintf(bflo(aw[2 * j]) * inv), a1 = (int)__builtin_rintf(bfhi(aw[2 * j]) * inv), a2 = (int)__builtin_rintf(bflo(aw[2 * j + 1]) * inv), a3 = (int)__builtin_rintf(bfhi(aw[2 * j + 1]) * inv);
                qa[j] = ((unsigned)a0 & 255u) | (((unsigned)a1 & 255u) << 8) | (((unsigned)a2 & 255u) << 16) | ((unsigned)a3 << 24); }
#pragma unroll
            for (int j = 0; j < 2; ++j) { const int c0 = (int)__builtin_rintf(yc[4 * j] * inv), c1 = (int)__builtin_rintf(yc[4 * j + 1] * inv), c2 = (int)__builtin_rintf(yc[4 * j + 2] * inv), c3 = (int)__builtin_rintf(yc[4 * j + 3] * inv);
                qc2[j] = ((unsigned)c0 & 255u) | (((unsigned)c1 & 255u) << 8) | (((unsigned)c2 & 255u) << 16) | ((unsigned)c3 << 24);
                const int l0 = (int)__builtin_rintf(yl[4 * j] * inv), l1 = (int)__builtin_rintf(yl[4 * j + 1] * inv), l2 = (int)__builtin_rintf(yl[4 * j + 2] * inv), l3 = (int)__builtin_rintf(yl[4 * j + 3] * inv);
                ql2[j] = ((unsigned)l0 & 255u) | (((unsigned)l1 & 255u) << 8) | (((unsigned)l2 & 255u) << 16) | ((unsigned)l3 << 24); }
            GAS v2u* orow = (GAS v2u*)(amix8 + t * D);
            orow[lane] = (v2u){qa[0], qa[1]}; orow[64 + lane] = (v2u){qa[2], qa[3]}; orow[128 + lane] = (v2u){qc2[0], qc2[1]}; orow[192 + lane] = (v2u){ql2[0], ql2[1]};
            if (lane == 0) asm_o[t] = mx * (1.f / 127.f) / ra_inv;
        }
    }
    __syncthreads();
}
template <int CTRL, int RM> __device__ __forceinline__ float dppf(float v) { return __builtin_bit_cast(float, __builtin_amdgcn_update_dpp(0, __builtin_bit_cast(int, v), CTRL, RM, 0xF, false)); }
__device__ __forceinline__ float wave_sum63(float v) { v += dppf<0xB1, 0xF>(v); v += dppf<0x4E, 0xF>(v); v += dppf<0x141, 0xF>(v); v += dppf<0x140, 0xF>(v); v += dppf<0x142, 0xA>(v); v += dppf<0x143, 0xC>(v); return v; }
__device__ __forceinline__ float wave_max63(float v) { v = fmaxf(v, dppf<0xB1, 0xF>(v)); v = fmaxf(v, dppf<0x4E, 0xF>(v)); v = fmaxf(v, dppf<0x141, 0xF>(v)); v = fmaxf(v, dppf<0x140, 0xF>(v)); v = fmaxf(v, dppf<0x142, 0xA>(v)); v = fmaxf(v, dppf<0x143, 0xC>(v)); return v; }
__device__ __forceinline__ void router_phase(const Args& A, const Frame& F, const bf16* xa) {
    unsigned char* ws = A.ws;
    const int lane = F.lane, w = F.wave;
    LAS float* RWL = (LAS float*)F.lds;
    LAS float* invs = (LAS float*)(F.lds + 65536);
    LAS unsigned* eblk = (LAS unsigned*)(F.lds + 65536 + 256);
    const float* gn = A.in[14] + D; const float* rw = A.in[18];
    float* as_o = (float*)(ws + WS_AS); signed char* xq = (signed char*)(ws + WS_XQ8); unsigned* toke = (unsigned*)(ws + WS_TOKE); float* tokw = (float*)(ws + WS_TOKW); unsigned* lrank = (unsigned*)(ws + WS_LRANK); int* blkcnt = (int*)(ws + WS_BLKCNT);
#pragma unroll
    for (int m = 0; m < 4; ++m) { const int k = F.tid + 512 * m; const float g = gn[k]; const f32x4 a = *(const GAS f32x4*)(rw + k * 8), b = *(const GAS f32x4*)(rw + k * 8 + 4);
        LAS float* p = RWL + (((k >> 9) * 8 + (k & 7)) * 64 + ((k >> 3) & 63)) * 8; *(LAS f32x4*)p = a * g; *(LAS f32x4*)(p + 4) = b * g; }
    __syncthreads();
    for (int blk = blockIdx.x; blk < T / 64; blk += F.G) {
#pragma unroll 1
        for (int i = 0; i < 8; ++i) { const int tl = 8 * w + i; const size_t t = (size_t)blk * 64 + tl;
            const GAS v4u* xr = (const GAS v4u*)(xa + t * D) + lane; v4u v[4];
#pragma unroll
            for (int j = 0; j < 4; ++j) v[j] = xr[64 * j];
            float acc[8], q = 0.f, mx = 0.f;
#pragma unroll
            for (int e = 0; e < 8; ++e) acc[e] = 0.f;
#pragma unroll
            for (int j = 0; j < 4; ++j) { const unsigned ww[4] = {v[j].x, v[j].y, v[j].z, v[j].w};
#pragma unroll
                for (int i8 = 0; i8 < 8; ++i8) { const float x = (i8 & 1) ? bfhi(ww[i8 >> 1]) : bflo(ww[i8 >> 1]);
                    const LAS float* p = RWL + ((j * 8 + i8) * 64 + lane) * 8; const f32x4 r0 = *(const LAS f32x4*)p, r1 = *(const LAS f32x4*)(p + 4);
                    acc[0] += x * r0.x; acc[1] += x * r0.y; acc[2] += x * r0.z; acc[3] += x * r0.w; acc[4] += x * r1.x; acc[5] += x * r1.y; acc[6] += x * r1.z; acc[7] += x * r1.w;
                    q += x * x; mx = fmaxf(mx, fabsf(x)); } }
#pragma unroll
            for (int e = 0; e < 8; ++e) acc[e] = wave_sum63(acc[e]);
            q = wave_sum63(q); mx = wave_max63(mx);
            if (lane == 63) { mx = fmaxf(mx, 1e-30f);
                const float rs = rsqrtf(q * (1.f / D) + EPS);
                int e1 = 0; float l1 = acc[0];
#pragma unroll
                for (int e = 1; e < 8; ++e) if (acc[e] > l1) { l1 = acc[e]; e1 = e; }
                int e2 = -1; float l2 = -__builtin_inff();
#pragma unroll
                for (int e = 0; e < 8; ++e) if (e != e1 && acc[e] > l2) { l2 = acc[e]; e2 = e; }
                const float w1 = 1.f / (1.f + expf((l2 - l1) * rs)), w2 = 1.f - w1;
                as_o[t] = mx * (1.f / 127.f) * rs; toke[t] = (unsigned)e1 | ((unsigned)e2 << 8); tokw[2 * t] = w1; tokw[2 * t + 1] = w2; eblk[tl] = (unsigned)e1 | ((unsigned)e2 << 8); invs[tl] = 127.f / mx; }
            LDS_WAIT();
            const float inv = invs[tl];
            GAS v2u* o8 = (GAS v2u*)(xq + t * D) + lane;
#pragma unroll
            for (int j = 0; j < 4; ++j) { const unsigned ww[4] = {v[j].x, v[j].y, v[j].z, v[j].w}; unsigned o[2];
#pragma unroll
                for (int h2 = 0; h2 < 2; ++h2) { const int a0 = (int)__builtin_rintf(bflo(ww[2 * h2]) * inv), a1 = (int)__builtin_rintf(bfhi(ww[2 * h2]) * inv), a2 = (int)__builtin_rintf(bflo(ww[2 * h2 + 1]) * inv), a3 = (int)__builtin_rintf(bfhi(ww[2 * h2 + 1]) * inv);
                    o[h2] = ((unsigned)a0 & 255u) | (((unsigned)a1 & 255u) << 8) | (((unsigned)a2 & 255u) << 16) | ((unsigned)a3 << 24); }
                o8[64 * j] = (v2u){o[0], o[1]}; }
        }
        __syncthreads();
        if (F.wave == 0) { const unsigned ev = eblk[lane]; const int e1 = ev & 255u, e2 = ev >> 8; const unsigned long long lower = (1ull << lane) - 1ull; unsigned r0 = 0, r1 = 0; int mycnt = 0;
#pragma unroll
            for (int e = 0; e < 8; ++e) { const unsigned long long m = __ballot(e1 == e) | __ballot(e2 == e); const int cnt = __popcll(m);
                if (e1 == e) r0 = (unsigned)__popcll(m & lower); if (e2 == e) r1 = (unsigned)__popcll(m & lower); if (lane == e) mycnt = cnt; }
            if (lane < 8) blkcnt[blk * 8 + lane] = mycnt;
            lrank[(size_t)blk * 64 + lane] = r0 | (r1 << 16); }
        __syncthreads();
    }
}
__device__ __forceinline__ void gather_phase(const Args& A, const Frame& F) {
    unsigned char* ws = A.ws;
    const float* as_i = (const float*)(ws + WS_AS); const unsigned* toke = (const unsigned*)(ws + WS_TOKE); const float* tokw = (const float*)(ws + WS_TOKW); const unsigned* lrank = (const unsigned*)(ws + WS_LRANK);
    const int* blkcnt = (const int*)(ws + WS_BLKCNT); int* seg = (int*)(ws + WS_SEG); int* pos_o = (int*)(ws + WS_POS); float* ass = (float*)(ws + WS_ASS); float* gws = (float*)(ws + WS_GWS);
    const signed char* xq = (const signed char*)(ws + WS_XQ8); signed char* xp = (signed char*)(ws + WS_XP);
    LAS int* sh = (LAS int*)F.lds;
    const int lane = F.lane;
    for (int blk = blockIdx.x; blk < T / 64; blk += F.G) {
        { const int e = F.wave; int tot = 0, pre = 0;
#pragma unroll
          for (int j = 0; j < 4; ++j) { const int idx = lane + 64 * j; const int c = blkcnt[idx * 8 + e]; tot += c; pre += (idx < blk) ? c : 0; }
          tot = wave_sum_i(tot); pre = wave_sum_i(pre);
          if (lane == 0) { sh[e] = tot; sh[8 + e] = pre; } }
        __syncthreads();
        if (F.tid == 0) { int s = 0;
            for (int e = 0; e < 8; ++e) { sh[16 + e] = s; s += (sh[e] + 255) & ~255; }
            sh[24] = s;
            if (blk == 0) { for (int e = 0; e < 9; ++e) seg[e] = sh[16 + e]; } }
        __syncthreads();
#pragma unroll 1
        for (int pi = F.wave * 16; pi < F.wave * 16 + 16; ++pi) { const int tl = pi >> 1, s = pi & 1; const size_t t = (size_t)blk * 64 + tl;
            const unsigned ev = toke[t], lr = lrank[t]; const int e = s ? (int)(ev >> 8) : (int)(ev & 255u); const int rank = s ? (int)(lr >> 16) : (int)(lr & 0xffffu);
            const int pos = sh[16 + e] + sh[8 + e] + rank;
            if (lane == 0) { pos_o[2 * t + s] = pos; ass[pos] = as_i[t]; gws[pos] = tokw[2 * t + s]; }
            const GAS v4u* src = (const GAS v4u*)(xq + t * D) + lane; GAS v4u* dst = (GAS v4u*)(xp + (size_t)pos * D) + lane;
#pragma unroll
            for (int j = 0; j < 2; ++j) dst[64 * j] = src[64 * j]; }
        __syncthreads();
    }
}
__device__ __forceinline__ void final_phase(const Args& A, const Frame& F, const bf16* xa, float* out) {
    const int gw = blockIdx.x * NWAVES + F.wave, NGW = F.G * NWAVES, lane = F.lane;
    const int* pos = (const int*)(A.ws + WS_POS); const bf16* Y = (const bf16*)(A.ws + WS_Y); const float* gf = A.in[22];
    for (int t = gw; t < T; t += NGW) { const int p0 = pos[2 * t], p1 = pos[2 * t + 1];
        const GAS v2u* xr = (const GAS v2u*)(xa + (size_t)t * D) + lane; const GAS v2u* y0 = (const GAS v2u*)(Y + (size_t)p0 * D) + lane; const GAS v2u* y1 = (const GAS v2u*)(Y + (size_t)p1 * D) + lane;
        GAS f32x4* orow = (GAS f32x4*)(out + (size_t)t * D) + lane;
        f32x4 v[8]; float q = 0.f;
#pragma unroll
        for (int j = 0; j < 8; ++j) { const v2u x = xr[64 * j], a = y0[64 * j], b = y1[64 * j];
            v[j].x = bflo(x.x) + bflo(a.x) + bflo(b.x); v[j].y = bfhi(x.x) + bfhi(a.x) + bfhi(b.x); v[j].z = bflo(x.y) + bflo(a.y) + bflo(b.y); v[j].w = bfhi(x.y) + bfhi(a.y) + bfhi(b.y);
            q += (v[j].x * v[j].x + v[j].y * v[j].y) + (v[j].z * v[j].z + v[j].w * v[j].w); }
        q = wave_sum(q); const float rs = rsqrtf(q * (1.f / D) + EPS);
#pragma unroll
        for (int j = 0; j < 8; ++j) { const f32x4 g = *((const GAS f32x4*)gf + lane + 64 * j); orow[64 * j] = v[j] * rs * g; }
    }
}

#ifndef REP_P0
#define REP_P0 1
#endif
#ifndef REP_T
#define REP_T 1
#endif
#ifndef REP_G
#define REP_G 1
#endif
__global__ void __launch_bounds__(NWAVES * 64, 2) hy_fwd(Args args) {
    extern __shared__ __attribute__((aligned(16))) unsigned char lds[];
    Frame F;
    F.lds = (LAS unsigned char*)lds;
    F.tid = threadIdx.x; F.lane = F.tid & 63; F.wave = __builtin_amdgcn_readfirstlane(F.tid >> 6); F.G = gridDim.x;
#define FRESH() do { int t_ = threadIdx.x; asm volatile("" : "+v"(t_)); F.tid = t_; F.lane = t_ & 63; F.wave = __builtin_amdgcn_readfirstlane(t_ >> 6); } while (0)
    unsigned char* ws = args.ws;
    for (int u = F.tid; u < (LDS_BYTES - LDSCTL_OFF) / 4; u += NWAVES * 64) ((LAS unsigned*)(F.lds + LDSCTL_OFF))[u] = 0u;
    __syncthreads();
    XcdBarrier bar; bar.bar = (unsigned*)(ws + WS_CTL) + CW_BAR; bar.x = 0; bar.st = nullptr;
#if !MK_PER_PHASE
    bar = xcd_barrier_post((unsigned*)(ws + WS_CTL) + CW_BAR, (volatile LAS unsigned*)(F.lds + MISC_OFF) + 8);
#endif
    const int lo = args.ph_lo, hi = args.ph_hi;
#define IN(k) (lo <= (k) && (k) < hi)
#if MK_PER_PHASE
#define SEAM(k) do { } while (0)
#else
#define SEAM(k) do { if (IN(k) && IN((k) + 1)) xcd_barrier(bar); } while (0)
#endif
    bf16* const PROJ = (bf16*)(ws + WS_PROJ); bf16* const AMIXB = (bf16*)(ws + WS_AMIXB); signed char* const AMIX8 = (signed char*)(ws + WS_AMIX8);
    float* const SSQA = (float*)(ws + WS_SSQA); float2* const LSUM = (float2*)(ws + WS_LSUM);
    const unsigned* const CM = (const unsigned*)(ws + WS_CMAX);
    bf16* const XA = (bf16*)(ws + WS_XA);
    bf16* const XB = (bf16*)(ws + WS_XB);

    if (IN(0)) { FRESH(); for (int rep = 0; rep < REP_P0; ++rep) p0_prologue(args, F); } SEAM(0);

#pragma unroll 1
    for (int l = 0; l < 2; ++l) {
        const int pb = 1 + 9 * l;
        if (IN(pb)) {
            pg8::Gemm g{(const bf16*)(ws + WS_XQ8), (const bf16*)(ws + WS_WIN + (size_t)l * DIN * D), T, DIN, D / 2}; pg8::GroupOrder S; S.init(T / 256, DIN, F.G, (int)blockIdx.x);
            pg8::EpiScaleBf16I8P E{PROJ, DIN, (const float*)(ws + WS_AS), CM + CM_IN + l * DIN, 0};
            for (int rep = 0; rep < REP_G; ++rep) pg8::gemm_phase<pg8::EpiScaleBf16I8P, pg8::GroupOrder, PG8_ALIGN, PG8_SP2>(F.lds, g, S, E);
            if (l == 0) { FRESH(); wout_quant(args, F); }
        } SEAM(pb);
        if (IN(pb + 1)) { FRESH();
            for (int rep = 0; rep < REP_T; ++rep) {
            for (int u = blockIdx.x; u < 256; u += F.G) attn_unit(F, u, PROJ, AMIXB, SSQA, args.in[3] + l * 16);
            for (int u = blockIdx.x; u < 256; u += F.G) { float dummy[64]; lru_chunk<false>(args, F, u, l, PROJ, LSUM, dummy, (bf16*)(ws + WS_HL), (bf16*)(ws + WS_PL)); }
            __syncthreads(); }
        } SEAM(pb + 1);
        if (IN(pb + 2)) { FRESH();
            for (int rep = 0; rep < REP_T; ++rep) for (int u = blockIdx.x; u < 256; u += F.G) mix_unit(args, F, u, l, PROJ, AMIXB, AMIX8, (float*)(ws + WS_ASM), SSQA, LSUM, (const bf16*)(ws + WS_HL), (const bf16*)(ws + WS_PL));
        } SEAM(pb + 2);
        if (IN(pb + 3)) {
            pg8::Gemm g{(const bf16*)AMIX8, (const bf16*)(ws + WS_WOUT + (size_t)l * D * D), T, D, D / 2}; pg8::GroupOrder S; S.init(T / 256, D, F.G, (int)blockIdx.x);
            pg8::EpiResidI8 E{l == 0 ? args.in[0] : (const float*)nullptr, XB, XA, (const float*)(ws + WS_ASM), CM + CM_OUT + l * D};
            for (int rep = 0; rep < REP_G; ++rep) pg8::gemm_phase<pg8::EpiResidI8, pg8::GroupOrder, PG8_ALIGN, PG8_SP2>(F.lds, g, S, E);
        } SEAM(pb + 3);
        if (l == 0) {
            if (IN(5)) { FRESH(); for (int rep = 0; rep < REP_T; ++rep) rowquant16_phase(args, F, XA); } SEAM(5);
            if (IN(6)) {
                pg8::Gemm g{(const bf16*)(ws + WS_XQ8), (const bf16*)(ws + WS_WGU), T, 2 * DFF, D / 2}; pg8::GroupOrder S; S.init(T / 256, 2 * DFF, F.G, (int)blockIdx.x);
                pg8::EpiSwigluI8P E{(bf16*)(ws + WS_ACT), DFF, (const float*)(ws + WS_AS), CM + CM_GU, 0};
                for (int rep = 0; rep < REP_G; ++rep) pg8::gemm_phase<pg8::EpiSwigluI8P, pg8::GroupOrder, PG8_ALIGN, PG8_SP2>(F.lds, g, S, E);
            } SEAM(6);
            if (IN(7)) { FRESH(); for (int rep = 0; rep < REP_T; ++rep) actquant_phase<DFF, 8>(F, (const bf16*)(ws + WS_ACT), (signed char*)(ws + WS_ACT8), (float*)(ws + WS_ASD), nullptr, T); } SEAM(7);
            if (IN(8)) {
                pg8::Gemm g{(const bf16*)(ws + WS_ACT8), (const bf16*)(ws + WS_WD), T, D, DFF / 2}; pg8::GroupOrder S; S.init(T / 256, D, F.G, (int)blockIdx.x);
                pg8::EpiResidI8 E{nullptr, XA, XB, (const float*)(ws + WS_ASD), CM + CM_D};
                for (int rep = 0; rep < REP_G; ++rep) pg8::gemm_phase<pg8::EpiResidI8, pg8::GroupOrder, PG8_ALIGN, PG8_SP2>(F.lds, g, S, E);
            } SEAM(8);
            if (IN(9)) { FRESH(); for (int rep = 0; rep < REP_T; ++rep) rowquant16_phase(args, F, XB); } SEAM(9);
        } else {
            if (IN(14)) { FRESH(); for (int rep = 0; rep < REP_T; ++rep) router_phase(args, F, XA); } SEAM(14);
            if (IN(15)) { FRESH(); for (int rep = 0; rep < REP_T; ++rep) gather_phase(args, F); } SEAM(15);
            if (IN(16)) {
                const int* seg = (const int*)(ws + WS_SEG);
                pg8::GroupOrder S; S.init(seg[8] >> 8, 2 * DE, F.G, (int)blockIdx.x); S.estride = (size_t)2 * DE * D;
#pragma unroll
                for (int e = 0; e < 9; ++e) S.pstart[e] = seg[e] >> 8;
                pg8::Gemm g{(const bf16*)(ws + WS_XP), (const bf16*)(ws + WS_EGU), MROWS, 2 * DE, D / 2};
                pg8::EpiSwigluI8P E{(bf16*)(ws + WS_ACTM), DE, (const float*)(ws + WS_ASS), CM + CM_EGU, 2 * DE};
                for (int rep = 0; rep < REP_G; ++rep) pg8::gemm_phase<pg8::EpiSwigluI8P, pg8::GroupOrder, PG8_ALIGN, PG8_SP2>(F.lds, g, S, E);
            } SEAM(16);
            if (IN(17)) { FRESH(); const int nrows = ((const int*)(ws + WS_SEG))[8];
                for (int rep = 0; rep < REP_T; ++rep) actquant_phase<DE, 4>(F, (const bf16*)(ws + WS_ACTM), (signed char*)(ws + WS_ACTM8), (float*)(ws + WS_ASDM), (const float*)(ws + WS_GWS), nrows); } SEAM(17);
            if (IN(18)) {
                const int* seg = (const int*)(ws + WS_SEG);
                pg8::GroupOrder S; S.init(seg[8] >> 8, D, F.G, (int)blockIdx.x); S.estride = (size_t)D * DE;
#pragma unroll
                for (int e = 0; e < 9; ++e) S.pstart[e] = seg[e] >> 8;
                pg8::Gemm g{(const bf16*)(ws + WS_ACTM8), (const bf16*)(ws + WS_ED), MROWS, D, DE / 2};
                pg8::EpiScaleBf16I8P E{(bf16*)(ws + WS_Y), D, (const float*)(ws + WS_ASDM), CM + CM_ED, D};
                for (int rep = 0; rep < REP_G; ++rep) pg8::gemm_phase<pg8::EpiScaleBf16I8P, pg8::GroupOrder, PG8_ALIGN, PG8_SP2>(F.lds, g, S, E);
            } SEAM(18);
            if (IN(19)) { FRESH(); final_phase(args, F, XA, args.out); }
        }
    }
#undef IN
#undef SEAM
}

extern "C" void kernel_launch(void* const* d_in, const int* in_sizes, int n_in, void* d_out, int out_size, void* d_ws, size_t ws_size, hipStream_t stream) {
    static int grid = 0;
    if (grid == 0) {
        if (n_in != 23 || in_sizes[0] != T * D || out_size != T * D || ws_size < WS_END) { fprintf(stderr, "kernel_launch: unexpected shapes / workspace (%d inputs, ws %zu, need %zu)\n", n_in, ws_size, (size_t)WS_END); grid = -1; return; }
        int dev = 0, cus = 0;
        if (hipGetDevice(&dev) != hipSuccess || hipDeviceGetAttribute(&cus, hipDeviceAttributeMultiprocessorCount, dev) != hipSuccess) { grid = -1; return; }
        if (hipFuncSetAttribute((const void*)hy_fwd, hipFuncAttributeMaxDynamicSharedMemorySize, LDS_BYTES) != hipSuccess) { fprintf(stderr, "kernel_launch: hipFuncSetAttribute failed\n"); grid = -1; return; }
        int per_cu = 0;
        if (hipOccupancyMaxActiveBlocksPerMultiprocessor(&per_cu, (const void*)hy_fwd, NWAVES * 64, LDS_BYTES) != hipSuccess || per_cu < 1) fprintf(stderr, "kernel_launch: occupancy query reports %d\n", per_cu);
        (void)hipGetLastError();
        grid = cus;
    }
    if (grid < 0) return;
    if (hipMemsetAsync((char*)d_ws + WS_CTL, 0, CTL_ZERO_BYTES, stream) != hipSuccess) return;
    Args a{};
    for (int i = 0; i < 23; ++i) a.in[i] = (const float*)d_in[i];
    a.out = (float*)d_out; a.ws = (unsigned char*)d_ws;
#if MK_PER_PHASE
    for (int ph = 0; ph < N_PHASES; ++ph) { a.ph_lo = ph; a.ph_hi = ph + 1; hipLaunchKernelGGL(hy_fwd, dim3(grid), dim3(NWAVES * 64), LDS_BYTES, stream, a); }
#else
    a.ph_lo = 0; a.ph_hi = N_PHASES; hipLaunchKernelGGL(hy_fwd, dim3(grid), dim3(NWAVES * 64), LDS_BYTES, stream, a);
#endif
}
```

```cpp
#include <hip/hip_runtime.h>
#include <cstdio>
#include <cstdint>
#ifndef MK_PER_PHASE
#define MK_PER_PHASE 0
#endif
namespace pg8 {
#define PG8_LAS __attribute__((address_space(3)))
typedef unsigned short bf16_t;
typedef short bf16x8 __attribute__((ext_vector_type(8)));
typedef float f32x4 __attribute__((ext_vector_type(4)));
typedef unsigned u32x4 __attribute__((ext_vector_type(4)));
typedef int i32x4 __attribute__((ext_vector_type(4)));
constexpr int BM = 256, BK = 64, HALF = 128, HTB = HALF * BK * 2  , STAGE_BYTES = 8 * HTB, NXCD = 8, WGM = 6, WGM_N8 = 3;

__host__ __device__ __forceinline__ int lds_byte(int r, int c) { const int st = (r >> 4) * 2 + (c >> 5), rr = r & 15, cc = c & 31, ob = rr * 64 + cc * 2; return st * 1024 + (ob ^ (((ob >> 9) & 1) << 5)); }
__host__ __device__ __forceinline__ void stage_rc(int b, int& R, int& C) { const int st = b / 1024, sb = b % 1024, swz = sb ^ (((sb >> 9) & 1) << 5); R = (st >> 1) * 16 + swz / 64; C = (st & 1) * 32 + (swz % 64) / 2; }
__host__ __device__ __forceinline__ int perm32(int rho) { const int n = rho >> 4, i = rho & 15; return 8 * (i >> 2) + 4 * n + (i & 3); }

struct Unit { int pm, pn, eid; size_t bofs; };
struct Gemm { const bf16_t* A; const bf16_t* Bt; int M, N, K; };

struct GroupOrder {
    int nM, nN, nwg, G, c, wgm; int pstart[9]; size_t estride;
    __device__ void init(int nM_, int N, int G_, int c_) { nM = nM_; nN = N / BM; nwg = nM * nN; G = G_; c = c_; estride = 0; wgm = (nN == 8) ? WGM_N8 : WGM;
#pragma unroll
        for (int e = 0; e < 9; ++e) pstart[e] = (e == 0) ? 0 : nM_; }
    __device__ bool next(int i, Unit& u) const {
        const long L = (long)i * G + c; if (L >= nwg) return false;
        int wgid = (int)L; { const int q = nwg / NXCD, r = nwg % NXCD, xcd = wgid % NXCD, off = wgid / NXCD; wgid = (xcd < r ? xcd * (q + 1) : r * (q + 1) + (xcd - r) * q) + off; }
        const int nig = wgm * nN, gid = wgid / nig, fm = gid * wgm, gsz = (nM - fm) < wgm ? (nM - fm) : wgm;
        u.pm = fm + ((wgid % nig) % gsz); u.pn = (wgid % nig) / gsz;
        int e = 0;
#pragma unroll
        for (int k = 1; k < 8; ++k) e += (u.pm >= pstart[k]) ? 1 : 0;
        u.eid = e; u.bofs = (size_t)e * estride; return true;
    }
    __device__ __forceinline__ void a_ready(const Unit&) const {}
    __device__ __forceinline__ void done(const Unit&) const {}
};

typedef float f32x2 __attribute__((ext_vector_type(2))); typedef __bf16 bf16x2_t __attribute__((ext_vector_type(2)));
__device__ __forceinline__ unsigned cvt_pk_bf16(float lo, float hi) { f32x2 v = {lo, hi}; bf16x2_t b = __builtin_convertvector(v, bf16x2_t); return __builtin_bit_cast(unsigned, b); }
__device__ __forceinline__ float silu_mul(float g, float u) { return g * u * __builtin_amdgcn_rcpf(1.f + __builtin_amdgcn_exp2f(-1.4426950408889634f * g)); }
struct EpiScaleBf16I8 {
    static constexpr bool PERM = true, AFTER_DRAIN = false, I8 = true, PREF = false; typedef i32x4 acc_t;
    bf16_t* O; int ldc; const float* rs; const unsigned* cmax; int ncol;
    __device__ __forceinline__ void operator()(const i32x4 (&acc)[2][2][4][2], const Unit& u, int wr, int wc, int fr, int fq) const {
        const int row0 = u.pm * BM + wr * 64 + fr, col0 = u.pn * BM + wc * 32 + 8 * fq;
        const unsigned* cm = cmax + (size_t)u.eid * ncol + col0;
        f32x4 sc[2][2];
#pragma unroll
        for (int bj = 0; bj < 2; ++bj)
#pragma unroll
            for (int n = 0; n < 2; ++n) sc[bj][n] = __builtin_bit_cast(f32x4, *(const u32x4*)(cm + bj * HALF + 4 * n)) * (1.f / 127.f);
#pragma unroll
        for (int ai = 0; ai < 2; ++ai)
#pragma unroll
            for (int m = 0; m < 4; ++m) { const int r = row0 + ai * HALF + m * 16; const float sa = rs[r]; bf16_t* rowp = O + (size_t)r * ldc + col0;
#pragma unroll
                for (int bj = 0; bj < 2; ++bj) { const f32x4 v0 = __builtin_convertvector(acc[ai][bj][m][0], f32x4) * (sc[bj][0] * sa), v1 = __builtin_convertvector(acc[ai][bj][m][1], f32x4) * (sc[bj][1] * sa);
                    u32x4 w; w.x = cvt_pk_bf16(v0[0], v0[1]); w.y = cvt_pk_bf16(v0[2], v0[3]); w.z = cvt_pk_bf16(v1[0], v1[1]); w.w = cvt_pk_bf16(v1[2], v1[3]);
                    *(u32x4*)(rowp + bj * HALF) = w; } }
    }
};
__device__ __forceinline__ void ld_base8i(const float* base32, const bf16_t* base16, size_t off, f32x4& b0, f32x4& b1) {
    if (base32) { b0 = *(const f32x4*)(base32 + off); b1 = *(const f32x4*)(base32 + off + 4); }
    else { const u32x4 w = *(const u32x4*)(base16 + off);
        b0 = (f32x4){__builtin_bit_cast(float, w.x << 16), __builtin_bit_cast(float, w.x & 0xffff0000u), __builtin_bit_cast(float, w.y << 16), __builtin_bit_cast(float, w.y & 0xffff0000u)};
        b1 = (f32x4){__builtin_bit_cast(float, w.z << 16), __builtin_bit_cast(float, w.z & 0xffff0000u), __builtin_bit_cast(float, w.w << 16), __builtin_bit_cast(float, w.w & 0xffff0000u)}; }
}
struct EpiResidI8 {
    static constexpr bool PERM = true, AFTER_DRAIN = false, I8 = true, PREF = false; static constexpr int NSTORE = 0; typedef i32x4 acc_t;
    const float* base32; const bf16_t* base; bf16_t* out; const float* rs; const unsigned* cmax;
    __device__ __forceinline__ void operator()(const i32x4 (&acc)[2][2][4][2], const Unit& u, int wr, int wc, int fr, int fq) const {
        const int row0 = u.pm * BM + wr * 64 + fr, col0 = u.pn * BM + wc * 32 + 8 * fq;
        const unsigned* cm = cmax + col0;
        f32x4 sc[2][2];
#pragma unroll
        for (int bj = 0; bj < 2; ++bj)
#pragma unroll
            for (int n = 0; n < 2; ++n) sc[bj][n] = __builtin_bit_cast(f32x4, *(const u32x4*)(cm + bj * HALF + 4 * n)) * (1.f / 127.f);
#pragma unroll
        for (int ai = 0; ai < 2; ++ai)
#pragma unroll
            for (int m = 0; m < 4; ++m) { const int r = row0 + ai * HALF + m * 16; const float sa = rs[r];
#pragma unroll
                for (int bj = 0; bj < 2; ++bj) { const size_t off = (size_t)r * 2048 + col0 + bj * HALF; f32x4 b0, b1; ld_base8i(base32, base, off, b0, b1);
                    const f32x4 v0 = b0 + __builtin_convertvector(acc[ai][bj][m][0], f32x4) * (sc[bj][0] * sa), v1 = b1 + __builtin_convertvector(acc[ai][bj][m][1], f32x4) * (sc[bj][1] * sa);
                    u32x4 w; w.x = cvt_pk_bf16(v0[0], v0[1]); w.y = cvt_pk_bf16(v0[2], v0[3]); w.z = cvt_pk_bf16(v1[0], v1[1]); w.w = cvt_pk_bf16(v1[2], v1[3]);
                    *(u32x4*)(out + off) = w; } }
    }
};
constexpr float EPSN = 1e-6f;
template <int MODE> __device__ __forceinline__ float rowscale(const float* p, int r, int fq) {
    if constexpr (MODE == 0) { return 1.f; }
    else if constexpr (MODE == 1) { const f32x4 a = *(const f32x4*)(p + (size_t)r * 32 + 8 * fq), b = *(const f32x4*)(p + (size_t)r * 32 + 8 * fq + 4);
        float s = ((a[0] + a[1]) + (a[2] + a[3])) + ((b[0] + b[1]) + (b[2] + b[3])); s += __shfl_xor(s, 16); s += __shfl_xor(s, 32); return rsqrtf(s * (1.f / 2048.f) + EPSN); }
    else if constexpr (MODE == 2) { const f32x4 a = *(const f32x4*)(p + (size_t)r * 16 + 4 * fq);
        float s = (a[0] + a[1]) + (a[2] + a[3]); s += __shfl_xor(s, 16); s += __shfl_xor(s, 32); return rsqrtf(s * (1.f / 1024.f) + EPSN); }
    else { return p[r]; }
}
__device__ __forceinline__ void ld_base8(const float* base32, const bf16_t* base16, size_t off, f32x4& b0, f32x4& b1) {
    if (base32) { b0 = *(const f32x4*)(base32 + off); b1 = *(const f32x4*)(base32 + off + 4); }
    else { const u32x4 w = *(const u32x4*)(base16 + off);
        b0 = (f32x4){__builtin_bit_cast(float, w.x << 16), __builtin_bit_cast(float, w.x & 0xffff0000u), __builtin_bit_cast(float, w.y << 16), __builtin_bit_cast(float, w.y & 0xffff0000u)};
        b1 = (f32x4){__builtin_bit_cast(float, w.z << 16), __builtin_bit_cast(float, w.z & 0xffff0000u), __builtin_bit_cast(float, w.w << 16), __builtin_bit_cast(float, w.w & 0xffff0000u)}; }
}
template <int MODE> struct EpiResidB {
    static constexpr bool PERM = true, AFTER_DRAIN = false, I8 = false, PREF = false; typedef f32x4 acc_t;
    const float* base32; const bf16_t* base16; bf16_t* out; const float* sp;
    __device__ __forceinline__ void operator()(const f32x4 (&acc)[2][2][4][2], const Unit& u, int wr, int wc, int fr, int fq) const {
        const int row0 = u.pm * BM + wr * 64 + fr, col0 = u.pn * BM + wc * 32 + 8 * fq;
#pragma unroll
        for (int ai = 0; ai < 2; ++ai)
#pragma unroll
            for (int m = 0; m < 4; ++m) { const int r = row0 + ai * HALF + m * 16; const float sc = rowscale<MODE>(sp, r, fq);
#pragma unroll
                for (int bj = 0; bj < 2; ++bj) { const size_t off = (size_t)r * 2048 + col0 + bj * HALF; f32x4 b0, b1; ld_base8(base32, base16, off, b0, b1);
                    const f32x4 v0 = b0 + acc[ai][bj][m][0] * sc, v1 = b1 + acc[ai][bj][m][1] * sc;
                    u32x4 w; w.x = cvt_pk_bf16(v0[0], v0[1]); w.y = cvt_pk_bf16(v0[2], v0[3]); w.z = cvt_pk_bf16(v1[0], v1[1]); w.w = cvt_pk_bf16(v1[2], v1[3]);
                    *(u32x4*)(out + off) = w; } }
    }
};
struct EpiSwigluI8 {
    static constexpr bool PERM = true, AFTER_DRAIN = false, I8 = true, PREF = false; typedef i32x4 acc_t;
    bf16_t* O; int ldc; const float* as; const unsigned* cmax; int ncol;
    __device__ __forceinline__ void operator()(const i32x4 (&acc)[2][2][4][2], const Unit& u, int wr, int wc, int fr, int fq) const {
        const int row0 = u.pm * BM + wr * 64 + fr, col0 = u.pn * HALF + wc * 32 + 8 * fq;
        const unsigned* cm = cmax + (size_t)u.eid * ncol + u.pn * BM + wc * 32 + 8 * fq;
        f32x4 sg[2], su[2];
#pragma unroll
        for (int n = 0; n < 2; ++n) { const u32x4 a = *(const u32x4*)(cm + 4 * n), b = *(const u32x4*)(cm + HALF + 4 * n);
            sg[n] = __builtin_bit_cast(f32x4, a) * (1.f / 127.f); su[n] = __builtin_bit_cast(f32x4, b) * (1.f / 127.f); }
#pragma unroll
        for (int ai = 0; ai < 2; ++ai)
#pragma unroll
            for (int m = 0; m < 4; ++m) { const int r = row0 + ai * HALF + m * 16; const float sa = as[r];
                const f32x4 g0 = __builtin_convertvector(acc[ai][0][m][0], f32x4) * (sg[0] * sa), g1 = __builtin_convertvector(acc[ai][0][m][1], f32x4) * (sg[1] * sa);
                const f32x4 u0 = __builtin_convertvector(acc[ai][1][m][0], f32x4) * (su[0] * sa), u1 = __builtin_convertvector(acc[ai][1][m][1], f32x4) * (su[1] * sa);
                u32x4 w; w.x = cvt_pk_bf16(silu_mul(g0[0], u0[0]), silu_mul(g0[1], u0[1])); w.y = cvt_pk_bf16(silu_mul(g0[2], u0[2]), silu_mul(g0[3], u0[3]));
                w.z = cvt_pk_bf16(silu_mul(g1[0], u1[0]), silu_mul(g1[1], u1[1])); w.w = cvt_pk_bf16(silu_mul(g1[2], u1[2]), silu_mul(g1[3], u1[3]));
                *(u32x4*)(O + (size_t)r * ldc + col0) = w; }
    }
};

constexpr int PREF_OFF = 131072;
__device__ __forceinline__ void pref_issue(const float* rs_rows, const unsigned* cm_cols, PG8_LAS unsigned char* lds, int buf, int wid, int lane) {
    asm volatile("" : "+v"(lane));
    const unsigned* src = (wid < 4) ? (const unsigned*)rs_rows : cm_cols;
    __builtin_amdgcn_global_load_lds(src + ((wid & 3) * 64 + lane), (PG8_LAS unsigned*)(lds + PREF_OFF + buf * 2048 + wid * 256), 4, 0, 0);
}
struct EpiScaleBf16I8P {
    static constexpr bool PERM = true, AFTER_DRAIN = false, I8 = true, PREF = true; typedef i32x4 acc_t;
    bf16_t* O; int ldc; const float* rs; const unsigned* cmax; int ncol;
    __device__ __forceinline__ void prefetch(const Unit& u, PG8_LAS unsigned char* lds, int buf, int wid, int lane) const { pref_issue(rs + (size_t)u.pm * BM, cmax + (size_t)u.eid * ncol + u.pn * BM, lds, buf, wid, lane); }
    __device__ __forceinline__ void operator()(const i32x4 (&acc)[2][2][4][2], const Unit& u, int wr, int wc, int fr, int fq, PG8_LAS unsigned char* lds, int buf) const {
        const int row0 = u.pm * BM + wr * 64 + fr, col0 = u.pn * BM + wc * 32 + 8 * fq;
        const PG8_LAS float* rsl = (const PG8_LAS float*)(lds + PREF_OFF + buf * 2048) + wr * 64 + fr; const PG8_LAS unsigned* cml = (const PG8_LAS unsigned*)(lds + PREF_OFF + buf * 2048 + 1024) + wc * 32 + 8 * fq;
        f32x4 sc[2][2];
#pragma unroll
        for (int bj = 0; bj < 2; ++bj)
#pragma unroll
            for (int n = 0; n < 2; ++n) sc[bj][n] = __builtin_bit_cast(f32x4, *(const PG8_LAS u32x4*)(cml + bj * HALF + 4 * n)) * (1.f / 127.f);
#pragma unroll
        for (int ai = 0; ai < 2; ++ai)
#pragma unroll
            for (int m = 0; m < 4; ++m) { const int r = row0 + ai * HALF + m * 16; const float sa = rsl[ai * HALF + m * 16]; bf16_t* rowp = O + (size_t)r * ldc + col0;
#pragma unroll
                for (int bj = 0; bj < 2; ++bj) { const f32x4 v0 = __builtin_convertvector(acc[ai][bj][m][0], f32x4) * (sc[bj][0] * sa), v1 = __builtin_convertvector(acc[ai][bj][m][1], f32x4) * (sc[bj][1] * sa);
                    u32x4 w; w.x = cvt_pk_bf16(v0[0], v0[1]); w.y = cvt_pk_bf16(v0[2], v0[3]); w.z = cvt_pk_bf16(v1[0], v1[1]); w.w = cvt_pk_bf16(v1[2], v1[3]);
                    *(u32x4*)(rowp + bj * HALF) = w; } }
    }
};
struct EpiResidI8P {
    static constexpr bool PERM = true, AFTER_DRAIN = false, I8 = true, PREF = true; typedef i32x4 acc_t;
    const bf16_t* base; bf16_t* out; const float* rs; const unsigned* cmax;
    __device__ __forceinline__ void prefetch(const Unit& u, PG8_LAS unsigned char* lds, int buf, int wid, int lane) const { pref_issue(rs + (size_t)u.pm * BM, cmax + u.pn * BM, lds, buf, wid, lane); }
    __device__ __forceinline__ void operator()(const i32x4 (&acc)[2][2][4][2], const Unit& u, int wr, int wc, int fr, int fq, PG8_LAS unsigned char* lds, int buf) const {
        const PG8_LAS float* rsl = (const PG8_LAS float*)(lds + PREF_OFF + buf * 2048) + wr * 64 + fr; const PG8_LAS unsigned* cml = (const PG8_LAS unsigned*)(lds + PREF_OFF + buf * 2048 + 1024) + wc * 32 + 8 * fq;
        const size_t off0 = (size_t)(u.pm * BM + wr * 64 + fr) * 2048 + u.pn * BM + wc * 32 + 8 * fq;
        u32x4 rb[2][4][2];
#pragma unroll
        for (int ai = 0; ai < 2; ++ai)
#pragma unroll
            for (int m = 0; m < 4; ++m)
#pragma unroll
                for (int bj = 0; bj < 2; ++bj) rb[ai][m][bj] = *(const u32x4*)(base + off0 + (size_t)(ai * HALF + m * 16) * 2048 + bj * HALF);
        __builtin_amdgcn_sched_barrier(0);
        f32x4 sc[2][2];
#pragma unroll
        for (int bj = 0; bj < 2; ++bj)
#pragma unroll
            for (int n = 0; n < 2; ++n) sc[bj][n] = __builtin_bit_cast(f32x4, *(const PG8_LAS u32x4*)(cml + bj * HALF + 4 * n)) * (1.f / 127.f);
#pragma unroll
        for (int ai = 0; ai < 2; ++ai)
#pragma unroll
            for (int m = 0; m < 4; ++m) { const float sa = rsl[ai * HALF + m * 16];
#pragma unroll
                for (int bj = 0; bj < 2; ++bj) { const u32x4 w0 = rb[ai][m][bj];
                    const f32x4 b0 = {__builtin_bit_cast(float, w0.x << 16), __builtin_bit_cast(float, w0.x & 0xffff0000u), __builtin_bit_cast(float, w0.y << 16), __builtin_bit_cast(float, w0.y & 0xffff0000u)};
                    const f32x4 b1 = {__builtin_bit_cast(float, w0.z << 16), __builtin_bit_cast(float, w0.z & 0xffff0000u), __builtin_bit_cast(float, w0.w << 16), __builtin_bit_cast(float, w0.w & 0xffff0000u)};
                    const f32x4 v0 = b0 + __builtin_convertvector(acc[ai][bj][m][0], f32x4) * (sc[bj][0] * sa), v1 = b1 + __builtin_convertvector(acc[ai][bj][m][1], f32x4) * (sc[bj][1] * sa);
                    u32x4 w; w.x = cvt_pk_bf16(v0[0], v0[1]); w.y = cvt_pk_bf16(v0[2], v0[3]); w.z = cvt_pk_bf16(v1[0], v1[1]); w.w = cvt_pk_bf16(v1[2], v1[3]);
                    *(u32x4*)(out + off0 + (size_t)(ai * HALF + m * 16) * 2048 + bj * HALF) = w; } }
    }
};
struct EpiSwigluI8P {
    static constexpr bool PERM = true, AFTER_DRAIN = false, I8 = true, PREF = true; typedef i32x4 acc_t;
    bf16_t* O; int ldc; const float* as; const unsigned* cmax; int ncol;
    __device__ __forceinline__ void prefetch(const Unit& u, PG8_LAS unsigned char* lds, int buf, int wid, int lane) const { pref_issue(as + (size_t)u.pm * BM, cmax + (size_t)u.eid * ncol + u.pn * BM, lds, buf, wid, lane); }
    __device__ __forceinline__ void operator()(const i32x4 (&acc)[2][2][4][2], const Unit& u, int wr, int wc, int fr, int fq, PG8_LAS unsigned char* lds, int buf) const {
        const int row0 = u.pm * BM + wr * 64 + fr, col0 = u.pn * HALF + wc * 32 + 8 * fq;
        const PG8_LAS float* rsl = (const PG8_LAS float*)(lds + PREF_OFF + buf * 2048) + wr * 64 + fr; const PG8_LAS unsigned* cml = (const PG8_LAS unsigned*)(lds + PREF_OFF + buf * 2048 + 1024) + wc * 32 + 8 * fq;
        f32x4 sg[2], su[2];
#pragma unroll
        for (int n = 0; n < 2; ++n) { sg[n] = __builtin_bit_cast(f32x4, *(const PG8_LAS u32x4*)(cml + 4 * n)) * (1.f / 127.f); su[n] = __builtin_bit_cast(f32x4, *(const PG8_LAS u32x4*)(cml + HALF + 4 * n)) * (1.f / 127.f); }
#pragma unroll
        for (int ai = 0; ai < 2; ++ai)
#pragma unroll
            for (int m = 0; m < 4; ++m) { const int r = row0 + ai * HALF + m * 16; const float sa = rsl[ai * HALF + m * 16];
                const f32x4 g0 = __builtin_convertvector(acc[ai][0][m][0], f32x4) * (sg[0] * sa), g1 = __builtin_convertvector(acc[ai][0][m][1], f32x4) * (sg[1] * sa);
                const f32x4 u0 = __builtin_convertvector(acc[ai][1][m][0], f32x4) * (su[0] * sa), u1 = __builtin_convertvector(acc[ai][1][m][1], f32x4) * (su[1] * sa);
                u32x4 w; w.x = cvt_pk_bf16(silu_mul(g0[0], u0[0]), silu_mul(g0[1], u0[1])); w.y = cvt_pk_bf16(silu_mul(g0[2], u0[2]), silu_mul(g0[3], u0[3]));
                w.z = cvt_pk_bf16(silu_mul(g1[0], u1[0]), silu_mul(g1[1], u1[1])); w.w = cvt_pk_bf16(silu_mul(g1[2], u1[2]), silu_mul(g1[3], u1[3]));
                *(u32x4*)(O + (size_t)r * ldc + col0) = w; }
    }
};
template <bool I8, class AccT> __device__ __forceinline__ AccT mma16(bf16x8 a, bf16x8 b, AccT c) {
    if constexpr (I8) return __builtin_amdgcn_mfma_i32_16x16x64_i8(__builtin_bit_cast(i32x4, a), __builtin_bit_cast(i32x4, b), c, 0, 0, 0);
    else return __builtin_amdgcn_mfma_f32_16x16x32_bf16(a, b, c, 0, 0, 0);
}
template <class Epi, class Sched, bool ALIGN_EPI = false, bool SP2 = false>
__device__ __forceinline__ void gemm_phase(PG8_LAS unsigned char* lds, const Gemm g, const Sched& S, const Epi& E) {
    int tid_ = threadIdx.x; asm volatile("" : "+v"(tid_));
    const int tid = tid_, wid = __builtin_amdgcn_readfirstlane(tid >> 6), lane = tid & 63, wr = wid >> 2, wc = wid & 3, fr = lane & 15, fq = lane >> 4;
    const int K = g.K, nt = K / BK;
    unsigned voffA[2], voffB[2];
#pragma unroll
    for (int i = 0; i < 2; ++i) { int R, C; stage_rc(tid * 16 + i * 8192, R, C); const int Rb = Epi::PERM ? ((R & ~31) + perm32(R & 31)) : R;
        voffA[i] = (unsigned)(R * K + C) * 2u; voffB[i] = (unsigned)(Rb * K + C) * 2u; }
    const size_t kstep = (size_t)(BK * 2);
    const size_t hstep = (size_t)HALF * K * 2;
    const size_t tstep = 2 * hstep;
    const unsigned ldsw = (unsigned)wid * 1024u;
    const int aoff = lds_byte(wr * 64 + fr, fq * 8), boff = lds_byte(wc * 32 + fr, fq * 8);
#define PG8_SA(b, h) (((b) * 2 + (h)) * HTB)
#define PG8_SB(b, h) ((4 + (b) * 2 + (h)) * HTB)
#define PG8_STAGE(bufoff, gbase, voff) do { _Pragma("unroll") for (int _i = 0; _i < 2; ++_i) \
        __builtin_amdgcn_global_load_lds((const unsigned*)((const char*)(gbase) + (voff)[_i]), (PG8_LAS unsigned*)(lds + (bufoff) + ldsw + _i * 8192), 16, 0, 0); } while (0)
#define PG8_LDA(dst, b, h) do { _Pragma("unroll") for (int m = 0; m < 4; ++m) _Pragma("unroll") for (int k = 0; k < 2; ++k) dst[m][k] = *(const PG8_LAS bf16x8*)(lds + PG8_SA(b, h) + aoff + m * 2048 + k * 1024); } while (0)
#define PG8_LDB(dst, b, h) do { _Pragma("unroll") for (int n = 0; n < 2; ++n) _Pragma("unroll") for (int k = 0; k < 2; ++k) dst[n][k] = *(const PG8_LAS bf16x8*)(lds + PG8_SB(b, h) + boff + n * 2048 + k * 1024); } while (0)
#define PG8_MMA(ai, bj, At, Bt) do { __builtin_amdgcn_s_setprio(1); _Pragma("unroll") for (int m = 0; m < 4; ++m) _Pragma("unroll") for (int n = 0; n < 2; ++n) _Pragma("unroll") for (int k = 0; k < 2; ++k) \
        acc[ai][bj][m][n] = mma16<Epi::I8>(Bt[n][k], At[m][k], acc[ai][bj][m][n]); __builtin_amdgcn_s_setprio(0); } while (0)
#define PG8_WAIT_V(n) asm volatile("s_waitcnt vmcnt(" #n ")" ::: "memory")
#define PG8_WAIT_L(n) asm volatile("s_waitcnt lgkmcnt(" #n ")" ::: "memory")
#define PG8_BAR __builtin_amdgcn_s_barrier()
#define PG8_SCHED __builtin_amdgcn_sched_barrier(0)
    Unit cur, nxt; int ui = 0;
    if (!S.next(0, cur)) return;
    typedef typename Epi::acc_t acc_t; acc_t acc[2][2][4][2];
#pragma unroll
    for (int a = 0; a < 2; ++a)
#pragma unroll
        for (int b = 0; b < 2; ++b)
#pragma unroll
            for (int m = 0; m < 4; ++m)
#pragma unroll
                for (int n = 0; n < 2; ++n) acc[a][b][m][n] = acc_t{};
    bf16x8 At[4][2], B0[2][2], B1[2][2];
    const char* cA = (const char*)g.A + (size_t)cur.pm * tstep; const char* cB = (const char*)g.Bt + cur.bofs + (size_t)cur.pn * tstep;
    S.a_ready(cur);
    int ubuf = 0;
    if constexpr (Epi::PREF) E.prefetch(cur, lds, ubuf, wid, lane);
    if constexpr (SP2) {
        PG8_STAGE(PG8_SB(0, 0), cB, voffB); PG8_STAGE(PG8_SB(0, 1), cB + hstep, voffB); PG8_STAGE(PG8_SA(0, 0), cA, voffA); PG8_STAGE(PG8_SA(0, 1), cA + hstep, voffA);
        if (wr == 1) PG8_BAR;
        PG8_WAIT_V(2); PG8_BAR;
        PG8_STAGE(PG8_SB(1, 0), cB + kstep, voffB); PG8_STAGE(PG8_SA(1, 0), cA + kstep, voffA); PG8_STAGE(PG8_SB(1, 1), cB + hstep + kstep, voffB);
        PG8_WAIT_V(6); PG8_BAR;
    } else {
        PG8_STAGE(PG8_SB(0, 0), cB, voffB); PG8_STAGE(PG8_SA(0, 0), cA, voffA); PG8_STAGE(PG8_SB(0, 1), cB + hstep, voffB); PG8_STAGE(PG8_SA(0, 1), cA + hstep, voffA);
        if (wr == 1) PG8_BAR;
        PG8_WAIT_V(4); PG8_BAR;
        PG8_STAGE(PG8_SB(1, 0), cB + kstep, voffB); PG8_STAGE(PG8_SA(1, 0), cA + kstep, voffA); PG8_STAGE(PG8_SB(1, 1), cB + hstep + kstep, voffB);
        PG8_WAIT_V(6); PG8_BAR;
    }
    for (;;) {
        const bool has_next = S.next(ui + 1, nxt);
        const char* nA = has_next ? (const char*)g.A + (size_t)nxt.pm * tstep : cA; const char* nB = has_next ? (const char*)g.Bt + nxt.bofs + (size_t)nxt.pn * tstep : cB;
        for (int t = 0; t < nt; t += 2) {
            const bool last = (t == nt - 2);
            const char* a1 = cA + (size_t)(t + 1) * kstep;
            const char* a2 = last ? nA : cA + (size_t)(t + 2) * kstep; const char* b2 = last ? nB : cB + (size_t)(t + 2) * kstep;
            const char* a3 = a2 + kstep; const char* b3 = b2 + kstep;
            if (last && has_next) S.a_ready(nxt);
            if constexpr (SP2) {
            PG8_LDB(B0, 0, 0); PG8_LDB(B1, 0, 1); PG8_SCHED; PG8_LDA(At, 0, 0); PG8_STAGE(PG8_SA(1, 1), a1 + hstep, voffA);
            PG8_WAIT_V(8); PG8_WAIT_L(0); PG8_BAR; PG8_MMA(0, 0, At, B0); PG8_MMA(0, 1, At, B1); PG8_BAR; PG8_SCHED;
            PG8_LDA(At, 0, 1); PG8_STAGE(PG8_SB(0, 0), b2, voffB); PG8_STAGE(PG8_SB(0, 1), b2 + hstep, voffB); PG8_STAGE(PG8_SA(0, 0), a2, voffA);
            PG8_WAIT_V(8); PG8_WAIT_L(0); PG8_BAR; PG8_MMA(1, 0, At, B0); PG8_MMA(1, 1, At, B1); PG8_BAR; PG8_SCHED;
            PG8_LDB(B0, 1, 0); PG8_LDB(B1, 1, 1); PG8_SCHED; PG8_LDA(At, 1, 0); PG8_STAGE(PG8_SA(0, 1), a2 + hstep, voffA);
            PG8_WAIT_V(8); PG8_WAIT_L(0); PG8_BAR; PG8_MMA(0, 0, At, B0); PG8_MMA(0, 1, At, B1); PG8_BAR; PG8_SCHED;
            PG8_LDA(At, 1, 1); PG8_STAGE(PG8_SB(1, 0), b3, voffB); PG8_STAGE(PG8_SB(1, 1), b3 + hstep, voffB); PG8_STAGE(PG8_SA(1, 0), a3, voffA);
            PG8_WAIT_V(8); PG8_WAIT_L(0); PG8_BAR; PG8_MMA(1, 0, At, B0); PG8_MMA(1, 1, At, B1); PG8_BAR; PG8_SCHED;
            } else {
            PG8_LDB(B0, 0, 0); PG8_SCHED; PG8_LDA(At, 0, 0); PG8_STAGE(PG8_SA(1, 1), a1 + hstep, voffA);
            PG8_WAIT_L(8); PG8_BAR; PG8_WAIT_L(0); PG8_MMA(0, 0, At, B0); PG8_BAR; PG8_SCHED;
            PG8_LDB(B1, 0, 1); PG8_STAGE(PG8_SB(0, 0), b2, voffB);
            PG8_BAR; PG8_WAIT_L(0); PG8_MMA(0, 1, At, B1); PG8_BAR;
            PG8_LDA(At, 0, 1); PG8_STAGE(PG8_SA(0, 0), a2, voffA);
            PG8_BAR; PG8_WAIT_L(0); PG8_MMA(1, 0, At, B0); PG8_BAR; PG8_SCHED;
            PG8_STAGE(PG8_SB(0, 1), b2 + hstep, voffB);
            PG8_WAIT_V(6); PG8_BAR; PG8_MMA(1, 1, At, B1); PG8_BAR;
            PG8_LDB(B0, 1, 0); PG8_SCHED; PG8_LDA(At, 1, 0); PG8_STAGE(PG8_SA(0, 1), a2 + hstep, voffA);
            PG8_WAIT_L(8); PG8_BAR; PG8_WAIT_L(0); PG8_MMA(0, 0, At, B0); PG8_BAR; PG8_SCHED;
            PG8_LDB(B1, 1, 1); PG8_STAGE(PG8_SB(1, 0), b3, voffB);
            PG8_BAR; PG8_WAIT_L(0); PG8_MMA(0, 1, At, B1); PG8_BAR;
            PG8_LDA(At, 1, 1); PG8_STAGE(PG8_SA(1, 0), a3, voffA);
            PG8_BAR; PG8_WAIT_L(0); PG8_MMA(1, 0, At, B0); PG8_BAR; PG8_SCHED;
            PG8_STAGE(PG8_SB(1, 1), b3 + hstep, voffB);
            PG8_WAIT_V(6); PG8_BAR; PG8_MMA(1, 1, At, B1); PG8_BAR;
            }
        }
        if constexpr (ALIGN_EPI) { if (wr == 0) PG8_BAR; }
        if constexpr (!Epi::AFTER_DRAIN) { if constexpr (Epi::PREF) E(acc, cur, wr, wc, fr, fq, lds, ubuf); else E(acc, cur, wr, wc, fr, fq); S.done(cur); }
        if (!has_next) break;
#pragma unroll
        for (int a = 0; a < 2; ++a)
#pragma unroll
            for (int b = 0; b < 2; ++b)
#pragma unroll
                for (int m = 0; m < 4; ++m)
#pragma unroll
                    for (int n = 0; n < 2; ++n) acc[a][b][m][n] = acc_t{};
        cur = nxt; cA = nA; cB = nB; ++ui;
        if constexpr (Epi::PREF) { ubuf ^= 1; E.prefetch(cur, lds, ubuf, wid, lane); }
        if constexpr (ALIGN_EPI) { if (wr == 1) PG8_BAR; }
    }
    PG8_WAIT_V(0);
    if constexpr (!ALIGN_EPI) { if (wr == 0) PG8_BAR; }
    PG8_BAR;
    if constexpr (Epi::AFTER_DRAIN) { E.fused(acc, cur, wr, wc, fr, fq, lds, wid, lane); S.done(cur); }
#undef PG8_SA
#undef PG8_SB
#undef PG8_STAGE
#undef PG8_LDA
#undef PG8_LDB
#undef PG8_MMA
#undef PG8_WAIT_V
#undef PG8_WAIT_L
#undef PG8_BAR
#undef PG8_SCHED
}
}
#ifndef PG8_SP2
#define PG8_SP2 true
#endif
#ifndef PG8_ALIGN
#define PG8_ALIGN true
#endif
constexpr int NWAVES = 8;
constexpr int BATCH = 4, SEQ = 4096, T = BATCH * SEQ, D = 2048, DIN = 3840, DFF = 5632, DE = 2816, NE = 8;
constexpr int C_Q = 0, C_K = 1024, C_V = 1152, C_CB = 1280, C_CC = 1792, C_CX = 2304, C_LX = 2816, C_LG = 3328;
constexpr int MAXP = 136, MROWS = MAXP * 256;
constexpr float EPS = 1e-6f, LOG2E = 1.4426950408889634f;
constexpr int N_PHASES = 20;
constexpr size_t MiB = 1u << 20, KiB = 1u << 10;
constexpr size_t WS_CTL = 0, CTL_ZERO_BYTES = 1 * MiB;
constexpr size_t WS_CMAX = 256 * KiB;
constexpr int CM_GU = 0, CM_EGU = 2 * DFF, CM_IN = CM_EGU + 8 * 2 * DE, CM_OUT = CM_IN + 2 * DIN, CM_D = CM_OUT + 2 * D, CM_ED = CM_D + D, CM_END = CM_ED + 8 * D;
constexpr size_t WS_SSQA = 3 * MiB;
constexpr size_t WS_LSUM = 4 * MiB;
constexpr size_t WS_AS = 5 * MiB;
constexpr size_t WS_TOKE = WS_AS + 64 * KiB;
constexpr size_t WS_TOKW = WS_TOKE + 64 * KiB;
constexpr size_t WS_LRANK = WS_TOKW + 128 * KiB;
constexpr size_t WS_POS = WS_LRANK + 64 * KiB;
constexpr size_t WS_BLKCNT = WS_POS + 128 * KiB;
constexpr size_t WS_SEG = WS_BLKCNT + 8 * KiB;
constexpr size_t WS_ASS = 6 * MiB;
constexpr size_t WS_GWS = WS_ASS + 256 * KiB;
constexpr size_t WS_ASM = WS_GWS + 256 * KiB;
constexpr size_t WS_ASD = WS_ASM + 64 * KiB;
constexpr size_t WS_ASDM = WS_ASD + 64 * KiB;
constexpr size_t WS_RWT = 8 * MiB;
constexpr size_t WS_WAT = 7 * MiB;
constexpr size_t WS_WXT = WS_WAT + 128 * KiB;
constexpr size_t WS_WIN = 17 * MiB;
constexpr size_t WS_WOUT = 32 * MiB;
constexpr size_t WS_WGU = 48 * MiB;
constexpr size_t WS_WD = 70 * MiB;
constexpr size_t WS_EGU = 81 * MiB;
constexpr size_t WS_ED = 169 * MiB;
constexpr size_t WS_XB = 213 * MiB;
constexpr size_t WS_XA = 277 * MiB;
constexpr size_t WS_XQ8 = 341 * MiB;
constexpr size_t WS_PROJ = 373 * MiB;
constexpr size_t WS_AMIXB = 493 * MiB;
constexpr size_t WS_AMIX8 = 525 * MiB;
constexpr size_t WS_WOF = 557 * MiB;
constexpr size_t WS_ACT = 373 * MiB;
constexpr size_t WS_ACT8 = 557 * MiB;
constexpr size_t WS_XP = 373 * MiB;
constexpr size_t WS_ACTM = 441 * MiB;
constexpr size_t WS_ACTM8 = 628 * MiB;
constexpr size_t WS_Y = 373 * MiB;
constexpr size_t WS_END = 722 * MiB;
static_assert(WS_CMAX + (size_t)CM_END * 4 <= CTL_ZERO_BYTES, "cmax");
static_assert(WS_WIN + 2ull * DIN * D <= WS_WOUT && WS_WOUT + 2ull * D * D * 2 <= WS_WGU && WS_WGU + 2ull * DFF * D <= WS_WD && WS_WD + (size_t)D * DFF <= WS_EGU && WS_EGU + 8ull * 2 * DE * D <= WS_ED && WS_ED + 8ull * D * DE <= WS_XB, "ws map 1");
static_assert(WS_XB + (size_t)T * D * 2 <= WS_XA && WS_XA + (size_t)T * D * 2 <= WS_XQ8 && WS_XQ8 + (size_t)T * D <= WS_PROJ && WS_PROJ + (size_t)T * DIN * 2 <= WS_AMIXB && WS_AMIXB + (size_t)T * 1024 * 2 <= WS_AMIX8 && WS_AMIX8 + (size_t)T * D <= WS_ACT8 && WS_WOF + 2ull * D * D * 4 <= WS_END, "ws map 2");
static_assert(WS_ACT + (size_t)T * DFF * 2 <= WS_ACT8 && WS_ACT8 + (size_t)T * DFF <= WS_END && WS_XP + (size_t)MROWS * D <= WS_ACTM && WS_ACTM + (size_t)MROWS * DE * 2 <= WS_ACTM8 && WS_ACTM8 + (size_t)MROWS * DE <= WS_END && WS_Y + (size_t)MROWS * D * 2 <= WS_ACTM8, "ws map 3");
constexpr int CW_BAR = 4096;
constexpr int RING_BYTES = 131072, LDSCTL_OFF = 143360, MISC_OFF = LDSCTL_OFF + 320, LDS_BYTES = 147456;
constexpr int LRU_WREG = 17408;
static_assert(8 * LRU_WREG <= LDSCTL_OFF, "LRU scratch");

#define GAS __attribute__((address_space(1)))
#define LAS __attribute__((address_space(3)))
typedef unsigned short bf16;
typedef unsigned v4u __attribute__((ext_vector_type(4)));
typedef unsigned v2u __attribute__((ext_vector_type(2)));
typedef float f32x4 __attribute__((ext_vector_type(4)));
typedef float f32x16 __attribute__((ext_vector_type(16)));
typedef short bf16x8 __attribute__((ext_vector_type(8)));
typedef GAS unsigned gu32;
#define RLX_AGENT __ATOMIC_RELAXED, __HIP_MEMORY_SCOPE_AGENT
#define LDS_WAIT() asm volatile("s_waitcnt lgkmcnt(0)" ::: "memory")
#define MFMA32(a, b, c) __builtin_amdgcn_mfma_f32_32x32x16_bf16((a), (b), (c), 0, 0, 0)
__device__ __forceinline__ unsigned f2bf(float f) { unsigned u = __builtin_bit_cast(unsigned, f); return (u + 0x7fffu + ((u >> 16) & 1u)) >> 16; }
__device__ __forceinline__ unsigned pk2(float lo, float hi) { return pg8::cvt_pk_bf16(lo, hi); }
__device__ __forceinline__ float bflo(unsigned w) { return __builtin_bit_cast(float, w << 16); }
__device__ __forceinline__ float bfhi(unsigned w) { return __builtin_bit_cast(float, w & 0xffff0000u); }
__device__ __forceinline__ float bf1(bf16 h) { return __builtin_bit_cast(float, (unsigned)h << 16); }
__device__ __forceinline__ float wave_sum(float v) {
#pragma unroll
    for (int o = 1; o < 64; o <<= 1) v += __shfl_xor(v, o);
    return v;
}
__device__ __forceinline__ int wave_sum_i(int v) {
#pragma unroll
    for (int o = 1; o < 64; o <<= 1) v += __shfl_xor(v, o);
    return v;
}
__device__ __forceinline__ float sigmoidf_(float x) { return __builtin_amdgcn_rcpf(1.f + __builtin_amdgcn_exp2f(-LOG2E * x)); }

#define XB_TMO      128
#define XB_XCNT(j)  (256  + 64 * (j))
#define XB_XSUB(j)  (1280 + 64 * (j))
#define XB_XGEN(j)  (2304 + 64 * (j))
#define XB_TOP      3328
#define XB_TOPGEN   3392
#define XCD_BAR_WORDS 3456
#define XB_SPIN_CAP (1u << 22)
__device__ __forceinline__ unsigned xb_ld(unsigned* p)              { return __hip_atomic_load(p, __ATOMIC_RELAXED, __HIP_MEMORY_SCOPE_AGENT); }
__device__ __forceinline__ unsigned xb_add(unsigned* p, unsigned v) { return __hip_atomic_fetch_add(p, v, __ATOMIC_RELAXED, __HIP_MEMORY_SCOPE_AGENT); }
__device__ __forceinline__ unsigned xb_xcc_id() { return (unsigned)__builtin_amdgcn_s_getreg((3 << 11) | 20) & 0xFu; }
#define XB_SPIN(cond, bar) do { unsigned _sp = 0; while (cond) { __builtin_amdgcn_s_sleep(1); \
    if ((++_sp & 255u) == 0u) { if (xb_ld(&(bar)[XB_TMO])) break; if (_sp > XB_SPIN_CAP) { atomicAdd(&(bar)[XB_TMO], 1u); break; } } } } while (0)
struct XcdBarrier { unsigned* bar; unsigned x; volatile LAS unsigned* st; };
__device__ __forceinline__ XcdBarrier xcd_barrier_post(unsigned* bar, volatile LAS unsigned* st) {
    XcdBarrier b; b.bar = bar; b.x = xb_xcc_id(); b.st = st;
    if (threadIdx.x == 0) (void)xb_add(&bar[XB_XCNT(b.x)], 1u);
    return b;
}
__device__ __forceinline__ void xcd_barrier_complete(unsigned* bar, unsigned x, unsigned& nloc, unsigned& nx) {
    const unsigned G = gridDim.x * gridDim.y * gridDim.z;
    unsigned sum, cnt, mine, sp = 0u;
    for (;;) {
        sum = 0u; cnt = 0u; mine = 0u;
#pragma unroll
        for (unsigned j = 0; j < 16; ++j) { const unsigned c = xb_ld(&bar[XB_XCNT(j)]); sum += c; cnt += (c > 0u) ? 1u : 0u; mine = (j == x) ? c : mine; }
        if (sum == G) break;
        __builtin_amdgcn_s_sleep(1);
        if ((++sp & 255u) == 0u) { if (xb_ld(&bar[XB_TMO])) break; if (sp > XB_SPIN_CAP) { atomicAdd(&bar[XB_TMO], 1u); break; } }
    }
    nloc = mine > 0u ? mine : 1u; nx = cnt > 0u ? cnt : 1u;
}
__device__ __forceinline__ void xcd_barrier(const XcdBarrier& b) {
    asm volatile("s_waitcnt vmcnt(0)" ::: "memory");
    __syncthreads();
    if (threadIdx.x == 0) {
        unsigned* bar = b.bar;
        __builtin_amdgcn_s_waitcnt(0);
        unsigned nloc = b.st[0], nx = b.st[1];
        if (nloc == 0u) { xcd_barrier_complete(bar, b.x, nloc, nx); b.st[0] = nloc; b.st[1] = nx; }
        const unsigned old = xb_add(&bar[XB_XSUB(b.x)], 1u);
        const unsigned gen = old / nloc;
        if (old + 1u == (gen + 1u) * nloc) {
            __builtin_amdgcn_fence(__ATOMIC_RELEASE, "agent");
            asm volatile("s_waitcnt vmcnt(0)" ::: "memory");
            const unsigned og = xb_add(&bar[XB_TOP], 1u);
            const unsigned tg = og / nx;
            if (og + 1u == (tg + 1u) * nx) xb_add(&bar[XB_TOPGEN], 1u);
            else XB_SPIN(xb_ld(&bar[XB_TOPGEN]) == tg, bar);
            __builtin_amdgcn_fence(__ATOMIC_ACQUIRE, "agent");
            xb_add(&bar[XB_XGEN(b.x)], 1u);
            asm volatile("s_waitcnt vmcnt(0)" ::: "memory");
        } else {
            XB_SPIN(xb_ld(&bar[XB_XGEN(b.x)]) == gen, bar);
            __builtin_amdgcn_fence(__ATOMIC_ACQUIRE, "agent");
            asm volatile("s_waitcnt vmcnt(0)" ::: "memory");
        }
    }
    __syncthreads();
}

struct Args { const float* in[23]; float* out; unsigned char* ws; int ph_lo, ph_hi; };
struct Frame {
    LAS unsigned char* lds;
    int tid, lane, wave, G;
};
template <int K, int NW, bool GAIN> __device__ __forceinline__ void quant_slab(const float* W, int N, const float* gain, signed char* WT, unsigned* cm, const Frame& F) {
    constexpr int RPW = 64 / NW, RSTEP = 8 * RPW, NV = K / RSTEP, RS = K + 4;
    constexpr bool PACK = NV > 128;
    static_assert(K % (4 * RSTEP) == 0 && NV % 4 == 0 && (NW * K / 16) % 512 == 0 && NW * RS + 1024 <= LDSCTL_OFF, "slab geometry");
    const int lane = F.lane, n = lane % NW, rq = lane / NW, w = F.wave;
    LAS unsigned char* T8 = (LAS unsigned char*)F.lds; LAS float* red = (LAS float*)(F.lds + NW * RS);
    const __amdgpu_buffer_rsrc_t rs = __builtin_amdgcn_make_buffer_rsrc((void*)W, 0, 0x7ffffff0, 0x00020000);
    const int kb = 4 * (RPW * w + rq);
    const unsigned vo = (unsigned)((kb * N + n) * 4);
#define SLAB_K(s) (4 * RSTEP * ((s) >> 2) + ((s) & 3))
#define SLAB_SO(s) ((unsigned)(SLAB_K(s) * N * 4))
    float m = 0.f;
    if constexpr (!PACK) {
        float v[NV];
#pragma unroll
        for (int s = 0; s < NV; ++s) v[s] = __builtin_bit_cast(float, __builtin_amdgcn_raw_buffer_load_b32(rs, vo, SLAB_SO(s), 0));
        if constexpr (GAIN) {
#pragma unroll
            for (int s = 0; s < NV; ++s) v[s] *= gain[SLAB_K(s) + kb]; }
#pragma unroll
        for (int s = 0; s < NV; ++s) m = fmaxf(m, fabsf(v[s]));
#pragma unroll
        for (int o = NW; o < 64; o <<= 1) m = fmaxf(m, __shfl_xor(m, o));
        if (rq == 0) red[w * NW + n] = m;
        __syncthreads();
#pragma unroll
        for (int i = 0; i < 8; ++i) m = fmaxf(m, red[i * NW + n]);
        if (w == 0 && rq == 0) cm[n] = __float_as_uint(m);
        const float inv = 127.f / fmaxf(m, 1e-30f);
#pragma unroll
        for (int s = 0; s < NV; s += 4) { const int a0 = (int)__builtin_rintf(v[s] * inv), a1 = (int)__builtin_rintf(v[s + 1] * inv), a2 = (int)__builtin_rintf(v[s + 2] * inv), a3 = (int)__builtin_rintf(v[s + 3] * inv);
            *(LAS unsigned*)(T8 + n * RS + SLAB_K(s) + kb) = ((unsigned)a0 & 255u) | (((unsigned)a1 & 255u) << 8) | (((unsigned)a2 & 255u) << 16) | ((unsigned)a3 << 24);
            if ((s & 28) == 28) __builtin_amdgcn_sched_barrier(0); }
    } else {
        unsigned pk[NV / 2];
        constexpr int BATCH = 16;
        static_assert(NV % BATCH == 0, "slab batch");
#pragma unroll
        for (int s0 = 0; s0 < NV; s0 += BATCH) { float x[BATCH];
#pragma unroll
            for (int i = 0; i < BATCH; ++i) x[i] = __builtin_bit_cast(float, __builtin_amdgcn_raw_buffer_load_b32(rs, vo, SLAB_SO(s0 + i), 0));
            if constexpr (GAIN) {
#pragma unroll
                for (int i = 0; i < BATCH; ++i) x[i] *= gain[SLAB_K(s0 + i) + kb]; }
#pragma unroll
            for (int i = 0; i < BATCH; i += 2) { m = fmaxf(m, fmaxf(fabsf(x[i]), fabsf(x[i + 1]))); unsigned p_ = pk2(x[i], x[i + 1]); asm volatile("" : "+v"(p_)); pk[(s0 + i) / 2] = p_; }
            asm volatile("" ::: "memory"); __builtin_amdgcn_sched_barrier(0); }
#pragma unroll
        for (int o = NW; o < 64; o <<= 1) m = fmaxf(m, __shfl_xor(m, o));
        if (rq == 0) red[w * NW + n] = m;
        __syncthreads();
#pragma unroll
        for (int i = 0; i < 8; ++i) m = fmaxf(m, red[i * NW + n]);
        if (w == 0 && rq == 0) cm[n] = __float_as_uint(m);
        const float inv = 127.f / fmaxf(m, 1e-30f);
#pragma unroll
        for (int s = 0; s < NV; s += 4) { const int a0 = (int)__builtin_rintf(bflo(pk[s / 2]) * inv), a1 = (int)__builtin_rintf(bfhi(pk[s / 2]) * inv), a2 = (int)__builtin_rintf(bflo(pk[s / 2 + 1]) * inv), a3 = (int)__builtin_rintf(bfhi(pk[s / 2 + 1]) * inv);
            *(LAS unsigned*)(T8 + n * RS + SLAB_K(s) + kb) = ((unsigned)a0 & 255u) | (((unsigned)a1 & 255u) << 8) | (((unsigned)a2 & 255u) << 16) | ((unsigned)a3 << 24);
            if ((s & 28) == 28) __builtin_amdgcn_sched_barrier(0); }
    }
#undef SLAB_K
#undef SLAB_SO
    __syncthreads();
#pragma unroll
    for (int j = 0; j < NW * K / 16 / 512; ++j) { const int ci = F.tid + 512 * j, nn = ci / (K / 16), c = ci % (K / 16);
        const LAS unsigned* src = (const LAS unsigned*)(T8 + nn * RS + 16 * c); v4u o; o.x = src[0]; o.y = src[1]; o.z = src[2]; o.w = src[3];
        *(GAS v4u*)(WT + (size_t)nn * K + 16 * c) = o;
        if ((j & 3) == 3) __builtin_amdgcn_sched_barrier(0); }
    __syncthreads();
}
__device__ __forceinline__ void wht_panel(const float* W, const float* gain, float* O, const Frame& F) {
    LAS float* L = (LAS float*)F.lds;
    const int t = F.tid, c4 = t & 7, r0 = t >> 3;
#pragma unroll
    for (int j = 0; j < 8; ++j) { const int k = r0 + 64 * j; const f32x4 v = *(const GAS f32x4*)(W + (size_t)k * D + 4 * c4) * gain[k]; LAS float* p = L + k * 33 + 4 * c4; p[0] = v.x; p[1] = v.y; p[2] = v.z; p[3] = v.w; }
    __syncthreads();
    const int col = t & 31, kq = t >> 5;
#pragma unroll 1
    for (int b = 0; b < 9; ++b) { const int bit = 1 << b;
        const int m = (b == 5) ? 56 : (b == 6) ? 120 : bit;
#pragma unroll 8
        for (int j = 0; j < 16; ++j) { const int idx = j * 16 + kq, k = ((idx >> b) << (b + 1)) | (idx & (bit - 1)); LAS float* p0 = L + k * 33 + col; LAS float* p1 = L + (k ^ m) * 33 + col; const float a = *p0, c = *p1; *p0 = a + c; *p1 = a - c; }
        __syncthreads(); }
#pragma unroll
    for (int j = 0; j < 8; ++j) { const int k = r0 + 64 * j; const LAS float* p = L + k * 33 + 4 * c4; *(GAS f32x4*)(O + (size_t)k * D + 4 * c4) = (f32x4){p[0], p[1], p[2], p[3]} * 0.04419417382415922f; }
    __syncthreads();
}
constexpr int S_GU = 176, S_EGU = 88, NSLAB_GU = 2 * S_GU + 16 * S_EGU;
constexpr int S_ED = 64, S_DD = 128, S_IN = 120, S_OUT = 64, NSLAB = 8 * S_ED + S_DD + 2 * S_IN + 2 * S_OUT + NSLAB_GU;
__device__ __forceinline__ void rowquant_phase(const Args& A, const Frame& F, const float* xa);
__device__ __forceinline__ void p0_prologue(const Args& A, const Frame& F) {
    unsigned char* ws = A.ws; unsigned* cm = (unsigned*)(ws + WS_CMAX);
    { float* wof = (float*)(ws + WS_WOF);
#pragma unroll 1
      for (int q = blockIdx.x; q < 2 * 2 * 64; q += F.G) { const int l = q >> 7, g = (q >> 6) & 1, n0 = 32 * (q & 63), kb = 1024 + 512 * g;
          wht_panel(A.in[13] + (size_t)l * D * D + (size_t)kb * D + n0, A.in[12] + l * D + kb, wof + (size_t)l * D * D + (size_t)kb * D + n0, F); }
      for (int o = blockIdx.x * 512 + F.tid; o < 2 * 1024 * (D / 4); o += F.G * 512) { const int l = o / (1024 * (D / 4)), r = o % (1024 * (D / 4)), k = r / (D / 4), c = r % (D / 4);
          *(GAS f32x4*)(wof + (size_t)l * D * D + (size_t)k * D + 4 * c) = *(const GAS f32x4*)(A.in[13] + (size_t)l * D * D + (size_t)k * D + 4 * c) * A.in[12][l * D + k]; } }
#pragma unroll 1
    for (int q = blockIdx.x; q < 8 * S_ED; q += F.G) { const int e = q / S_ED, n0 = 32 * (q % S_ED);
        quant_slab<2816, 32, false>(A.in[21] + (size_t)e * DE * D + n0, D, nullptr, (signed char*)(ws + WS_ED) + (size_t)e * D * DE + (size_t)n0 * DE, cm + CM_ED + e * D + n0, F); }
#pragma unroll 1
    for (int q = blockIdx.x; q < S_DD; q += F.G) { const int n0 = 16 * q;
        quant_slab<5632, 16, false>(A.in[17] + n0, D, nullptr, (signed char*)(ws + WS_WD) + (size_t)n0 * DFF, cm + CM_D + n0, F); }
#pragma unroll 1
    for (int q = (blockIdx.x + F.G - (S_DD % F.G)) % F.G; q < (2 * S_IN + NSLAB_GU) / 2; q += F.G) {
        const float* src; int N; const float* gain; signed char* dst; unsigned* cmb;
        if (q < S_IN) { const int l = q / (S_IN / 2), n0 = 64 * (q % (S_IN / 2)); src = A.in[2] + (size_t)l * D * DIN + n0; N = DIN; gain = A.in[1] + l * D; dst = (signed char*)(ws + WS_WIN) + (size_t)l * DIN * D + (size_t)n0 * D; cmb = cm + CM_IN + l * DIN + n0; }
        else { const int q3 = q - S_IN; int il, sl; const float* s0; signed char* d0; unsigned* c0;
            if (q3 < S_GU) { const int w_ = q3 / (S_GU / 2); s0 = A.in[15 + w_]; N = DFF; gain = A.in[14]; il = w_; c0 = cm + CM_GU; d0 = (signed char*)(ws + WS_WGU); sl = q3 % (S_GU / 2); }
            else { const int r2 = q3 - S_GU, w_ = r2 / (8 * (S_EGU / 2)), e_ = (r2 / (S_EGU / 2)) % 8; s0 = A.in[19 + w_] + (size_t)e_ * D * DE; N = DE; gain = A.in[14] + D; il = w_; c0 = cm + CM_EGU + e_ * 2 * DE; d0 = (signed char*)(ws + WS_EGU) + (size_t)e_ * 2 * DE * D; sl = r2 % (S_EGU / 2); }
            const int n0 = 64 * sl, drow0 = 256 * (n0 >> 7) + 128 * il + (n0 & 127); src = s0 + n0; dst = d0 + (size_t)drow0 * D; cmb = c0 + drow0; }
        quant_slab<2048, 64, true>(src, N, gain, dst, cmb, F);
    }
    for (int o = blockIdx.x * 512 + F.tid; o < 2 * 8 * 64 * 64; o += F.G * 512) { const int i = o & 63, j = (o >> 6) & 63, lh = o >> 12; const size_t src = ((size_t)lh * 64 + i) * 64 + j;
        ((bf16*)(ws + WS_WAT))[o] = (bf16)f2bf(A.in[7][src]); ((bf16*)(ws + WS_WXT))[o] = (bf16)f2bf(A.in[9][src]); }
    for (int o = blockIdx.x * 512 + F.tid; o < D * 8; o += F.G * 512) { const int k = o >> 3, e = o & 7; const float v = A.in[18][o] * A.in[14][D + k];
        const unsigned hi_ = f2bf(v); const float r_ = v - __builtin_bit_cast(float, hi_ << 16); ((bf16*)(ws + WS_RWT))[e * D + k] = (bf16)hi_; ((bf16*)(ws + WS_RWT))[8 * D + e * D + k] = (bf16)f2bf(r_); }
    rowquant_phase(A, F, A.in[0]);
}
__device__ __forceinline__ void rowquant_phase(const Args& A, const Frame& F, const float* xa) {
    const int gw = blockIdx.x * NWAVES + F.wave, NGW = F.G * NWAVES, lane = F.lane;
    signed char* xq = (signed char*)(A.ws + WS_XQ8); float* as = (float*)(A.ws + WS_AS); bf16* xb = (bf16*)(A.ws + WS_XB);
    for (int m = gw; m < T; m += NGW) {
        const GAS f32x4* xr = (const GAS f32x4*)(xa + (size_t)m * D) + lane; f32x4 v[8]; float q = 0.f, mx = 0.f;
#pragma unroll
        for (int j = 0; j < 8; ++j) { v[j] = xr[64 * j]; q += (v[j].x * v[j].x + v[j].y * v[j].y) + (v[j].z * v[j].z + v[j].w * v[j].w);
            mx = fmaxf(fmaxf(mx, fmaxf(fabsf(v[j].x), fabsf(v[j].y))), fmaxf(fabsf(v[j].z), fabsf(v[j].w))); }
        q = wave_sum(q);
#pragma unroll
        for (int o = 1; o < 64; o <<= 1) mx = fmaxf(mx, __shfl_xor(mx, o));
        mx = fmaxf(mx, 1e-30f); const float inv = 127.f / mx;
        GAS unsigned* o4 = (GAS unsigned*)(xq + (size_t)m * D) + lane; GAS v2u* ob = (GAS v2u*)(xb + (size_t)m * D) + lane;
#pragma unroll
        for (int j = 0; j < 8; ++j) { ob[64 * j] = (v2u){pk2(v[j].x, v[j].y), pk2(v[j].z, v[j].w)}; const int a0 = (int)__builtin_rintf(v[j].x * inv), a1 = (int)__builtin_rintf(v[j].y * inv), a2 = (int)__builtin_rintf(v[j].z * inv), a3 = (int)__builtin_rintf(v[j].w * inv);
            o4[64 * j] = ((unsigned)a0 & 255u) | (((unsigned)a1 & 255u) << 8) | (((unsigned)a2 & 255u) << 16) | ((unsigned)a3 << 24); }
        if (lane == 0) as[m] = mx * (1.f / 127.f) * rsqrtf(q * (1.f / D) + EPS);
    }
}

template <int NCOL, int VEC> __device__ __forceinline__ void actquant_phase(const Frame& F, const bf16* src, signed char* dst, float* sc, const float* gws, int nrows) {
    constexpr int CH = NCOL / VEC / 64, NW32 = VEC / 2;
    static_assert(NCOL % (VEC * 64) == 0, "act row geometry");
    const int gw = blockIdx.x * NWAVES + F.wave, NGW = F.G * NWAVES, lane = F.lane;
    for (int m = gw; m < nrows; m += NGW) {
        unsigned w[CH][NW32]; float mx = 0.f;
#pragma unroll
        for (int j = 0; j < CH; ++j) {
            if constexpr (VEC == 8) { const v4u r = ((const GAS v4u*)(src + (size_t)m * NCOL))[lane + 64 * j]; w[j][0] = r.x; w[j][1] = r.y; w[j][2] = r.z; w[j][3] = r.w; }
            else { const v2u r = ((const GAS v2u*)(src + (size_t)m * NCOL))[lane + 64 * j]; w[j][0] = r.x; w[j][1] = r.y; }
#pragma unroll
            for (int i = 0; i < NW32; ++i) mx = fmaxf(mx, fmaxf(fabsf(bflo(w[j][i])), fabsf(bfhi(w[j][i])))); }
#pragma unroll
        for (int o = 1; o < 64; o <<= 1) mx = fmaxf(mx, __shfl_xor(mx, o));
        mx = fmaxf(mx, 1e-30f); const float inv = 127.f / mx;
#pragma unroll
        for (int j = 0; j < CH; ++j) { unsigned o[NW32 / 2];
#pragma unroll
            for (int i = 0; i < NW32 / 2; ++i) { const int a0 = (int)__builtin_rintf(bflo(w[j][2 * i]) * inv), a1 = (int)__builtin_rintf(bfhi(w[j][2 * i]) * inv), a2 = (int)__builtin_rintf(bflo(w[j][2 * i + 1]) * inv), a3 = (int)__builtin_rintf(bfhi(w[j][2 * i + 1]) * inv);
                o[i] = ((unsigned)a0 & 255u) | (((unsigned)a1 & 255u) << 8) | (((unsigned)a2 & 255u) << 16) | ((unsigned)a3 << 24); }
            if constexpr (VEC == 8) { v2u ov; ov.x = o[0]; ov.y = o[1]; ((GAS v2u*)(dst + (size_t)m * NCOL))[lane + 64 * j] = ov; }
            else ((GAS unsigned*)(dst + (size_t)m * NCOL))[lane + 64 * j] = o[0]; }
        if (lane == 0) sc[m] = mx * (1.f / 127.f) * (gws ? gws[m] : 1.f);
    }
}

__device__ __forceinline__ void rowquant16_phase(const Args& A, const Frame& F, const bf16* xa) {
    const int gw = blockIdx.x * NWAVES + F.wave, NGW = F.G * NWAVES, lane = F.lane;
    signed char* xq = (signed char*)(A.ws + WS_XQ8); float* as = (float*)(A.ws + WS_AS);
    for (int m0 = gw; m0 < T; m0 += 2 * NGW) {
        const int m1 = (m0 + NGW < T) ? m0 + NGW : m0;
        v4u v[2][4];
#pragma unroll
        for (int r = 0; r < 2; ++r) { const GAS v4u* xr = (const GAS v4u*)(xa + (size_t)(r ? m1 : m0) * D) + lane;
#pragma unroll
            for (int j = 0; j < 4; ++j) v[r][j] = xr[64 * j]; }
#pragma unroll
        for (int r = 0; r < 2; ++r) { const int m = r ? m1 : m0; float q = 0.f, mx = 0.f;
#pragma unroll
            for (int j = 0; j < 4; ++j) { const unsigned ww[4] = {v[r][j].x, v[r][j].y, v[r][j].z, v[r][j].w};
#pragma unroll
                for (int i = 0; i < 4; ++i) { const float a = bflo(ww[i]), b = bfhi(ww[i]); q += a * a + b * b; mx = fmaxf(mx, fmaxf(fabsf(a), fabsf(b))); } }
            q = wave_sum(q);
#pragma unroll
            for (int o = 1; o < 64; o <<= 1) mx = fmaxf(mx, __shfl_xor(mx, o));
            mx = fmaxf(mx, 1e-30f); const float inv = 127.f / mx;
            GAS v2u* o8 = (GAS v2u*)(xq + (size_t)m * D) + lane;
#pragma unroll
            for (int j = 0; j < 4; ++j) { const unsigned ww[4] = {v[r][j].x, v[r][j].y, v[r][j].z, v[r][j].w}; unsigned o[2];
#pragma unroll
                for (int i = 0; i < 2; ++i) { const int a0 = (int)__builtin_rintf(bflo(ww[2 * i]) * inv), a1 = (int)__builtin_rintf(bfhi(ww[2 * i]) * inv), a2 = (int)__builtin_rintf(bflo(ww[2 * i + 1]) * inv), a3 = (int)__builtin_rintf(bfhi(ww[2 * i + 1]) * inv);
                    o[i] = ((unsigned)a0 & 255u) | (((unsigned)a1 & 255u) << 8) | (((unsigned)a2 & 255u) << 16) | ((unsigned)a3 << 24); }
                o8[64 * j] = (v2u){o[0], o[1]}; }
            if (lane == 0) as[m] = mx * (1.f / 127.f) * rsqrtf(q * (1.f / D) + EPS); }
    }
}

__device__ __forceinline__ void wout_quant(const Args& A, const Frame& F) {
    unsigned char* ws = A.ws;
#pragma unroll 1
    for (int q = (int)((blockIdx.x + 64) % F.G); q < 64; q += F.G) { const int l = q >> 5, n0 = 64 * (q & 31);
        quant_slab<2048, 64, false>((const float*)(ws + WS_WOF) + (size_t)l * D * D + n0, D, nullptr, (signed char*)(ws + WS_WOUT) + (size_t)l * D * D + (size_t)n0 * D, (unsigned*)(ws + WS_CMAX) + CM_OUT + l * D + n0, F); }
}
__device__ __forceinline__ void attn_unit(const Frame& F, int unit, const bf16* proj, bf16* amix, float* ssqa, const float* sinks) {
    const int b = unit >> 6, nb = (unit >> 1) & 31, kvh = unit & 1;
    const int tok0 = b * SEQ + nb * 128;
    LAS bf16* Ks = (LAS bf16*)(F.lds);
    LAS bf16* Vt = (LAS bf16*)(F.lds + 36864);
#pragma unroll
    for (int i = F.tid; i < 2048; i += 512) {
        const int kw = i >> 3, c = i & 7; const bool valid = (nb > 0) || (kw >= 128);
        v4u kv = {0u, 0u, 0u, 0u}, vv = {0u, 0u, 0u, 0u};
        if (valid) { const bf16* rp = proj + (size_t)(tok0 - 128 + kw) * DIN; kv = *(const GAS v4u*)(rp + C_K + kvh * 64 + c * 8); vv = *(const GAS v4u*)(rp + C_V + kvh * 64 + c * 8); }
        *(LAS v4u*)(Ks + kw * 72 + c * 8) = kv;
        LAS bf16* vp = Vt + (c * 8) * 264 + kw;
        vp[0 * 264] = (bf16)(vv.x & 0xffffu); vp[1 * 264] = (bf16)(vv.x >> 16); vp[2 * 264] = (bf16)(vv.y & 0xffffu); vp[3 * 264] = (bf16)(vv.y >> 16);
        vp[4 * 264] = (bf16)(vv.z & 0xffffu); vp[5 * 264] = (bf16)(vv.z >> 16); vp[6 * 264] = (bf16)(vv.w & 0xffffu); vp[7 * 264] = (bf16)(vv.w >> 16);
    }
    __syncthreads();
    const int h = kvh * 8 + F.wave, lane = F.lane, ql = lane & 31, hi = lane >> 5;
    const float sink2 = sinks[h] * LOG2E; const float SC = 0.125f * LOG2E; const float NEG = -__builtin_inff();
    bf16x8 qf[4], qn[4];
#pragma unroll
    for (int ks = 0; ks < 4; ++ks) { qf[ks] = *(const GAS bf16x8*)(proj + ((size_t)tok0 + ql) * DIN + C_Q + h * 64 + 16 * ks + 8 * hi); qn[ks] = qf[ks]; }
#pragma unroll 1
    for (int qs = 0; qs < 128; qs += 32) {
        const size_t tq = (size_t)tok0 + qs + ql;
        if (qs + 32 < 128) {
#pragma unroll
            for (int ks = 0; ks < 4; ++ks) qn[ks] = *(const GAS bf16x8*)(proj + (tq + 32) * DIN + C_Q + h * 64 + 16 * ks + 8 * hi); }
        f32x16 s[5];
#pragma unroll
        for (int kt = 0; kt < 5; ++kt) { f32x16 a = {};
#pragma unroll
            for (int ks = 0; ks < 4; ++ks) { const bf16x8 kf = *(const LAS bf16x8*)(Ks + (qs + 32 * kt + ql) * 72 + 16 * ks + 8 * hi); a = MFMA32(kf, qf[ks], a); }
            s[kt] = a; }
#pragma unroll
        for (int i = 0; i < 16; ++i) { const int kk = (i & 3) + 8 * (i >> 2) + 4 * hi; s[0][i] = (kk > ql) ? s[0][i] : NEG; s[4][i] = (kk <= ql) ? s[4][i] : NEG; }
        if (nb == 0) {
#pragma unroll
            for (int kt = 0; kt < 5; ++kt)
#pragma unroll
                for (int i = 0; i < 16; ++i) { const int kw = qs + 32 * kt + (i & 3) + 8 * (i >> 2) + 4 * hi; s[kt][i] = (kw >= 128) ? s[kt][i] : NEG; } }
        float mr = NEG;
#pragma unroll
        for (int kt = 0; kt < 5; ++kt)
#pragma unroll
            for (int i = 0; i < 16; i += 2) mr = fmaxf(fmaxf(mr, s[kt][i]), s[kt][i + 1]);
        mr = fmaxf(mr, __shfl_xor(mr, 32));
        const float mx = fmaxf(mr * SC, sink2);
        float sum = 0.f;
#pragma unroll
        for (int kt = 0; kt < 5; ++kt)
#pragma unroll
            for (int i = 0; i < 16; ++i) { const float p = __builtin_amdgcn_exp2f(__builtin_fmaf(s[kt][i], SC, -mx)); s[kt][i] = p; sum += p; }
        sum += __shfl_xor(sum, 32);
        const float inv = 1.f / (sum + __builtin_amdgcn_exp2f(sink2 - mx));
        f32x16 o[2]; o[0] = (f32x16){}; o[1] = (f32x16){};
#pragma unroll
        for (int kt = 0; kt < 5; ++kt)
#pragma unroll
            for (int st = 0; st < 2; ++st) {
                v4u pw; pw.x = pk2(s[kt][8 * st + 0], s[kt][8 * st + 1]); pw.y = pk2(s[kt][8 * st + 2], s[kt][8 * st + 3]); pw.z = pk2(s[kt][8 * st + 4], s[kt][8 * st + 5]); pw.w = pk2(s[kt][8 * st + 6], s[kt][8 * st + 7]);
                const bf16x8 pf = __builtin_bit_cast(bf16x8, pw);
                const int kbase = qs + 32 * kt + 16 * st + 4 * hi;
#pragma unroll
                for (int dt = 0; dt < 2; ++dt) { const LAS bf16* vp = Vt + (dt * 32 + ql) * 264 + kbase; const v2u lo = *(const LAS v2u*)vp, hi8 = *(const LAS v2u*)(vp + 8);
                    v4u vw; vw.x = lo.x; vw.y = lo.y; vw.z = hi8.x; vw.w = hi8.y; o[dt] = MFMA32(__builtin_bit_cast(bf16x8, vw), pf, o[dt]); }
            }
        float q = 0.f;
#pragma unroll
        for (int dt = 0; dt < 2; ++dt)
#pragma unroll
            for (int g4 = 0; g4 < 4; ++g4) { const float v0 = o[dt][4 * g4] * inv, v1 = o[dt][4 * g4 + 1] * inv, v2 = o[dt][4 * g4 + 2] * inv, v3 = o[dt][4 * g4 + 3] * inv;
                q += (v0 * v0 + v1 * v1) + (v2 * v2 + v3 * v3); v2u w; w.x = pk2(v0, v1); w.y = pk2(v2, v3);
                *(GAS v2u*)(amix + tq * 1024 + h * 64 + dt * 32 + 8 * g4 + 4 * hi) = w; }
        q += __shfl_xor(q, 32);
        if (hi == 0) ssqa[tq * 16 + h] = q;
#pragma unroll
        for (int ks = 0; ks < 4; ++ks) qf[ks] = qn[ks];
    }
    __syncthreads();
}

__device__ __forceinline__ float gelu_tanh(float x) { const float z = 0.7978845608028654f * (x + 0.044715f * x * x * x); return x * sigmoidf_(2.f * z); }
template <bool FULL> __device__ __forceinline__ void lru_chunk(const Args& A, const Frame& F, int unit, int layer, const bf16* proj, float2* lsum, float (&y)[64]) {
    const int b = unit >> 6, c64 = unit & 63, hh = F.wave, lane = F.lane, tl = lane & 31, hi = lane >> 5;
    const int ch0 = hh * 64, s0 = c64 * 64; const size_t t0 = (size_t)b * SEQ + s0;
    LAS float* XA = (LAS float*)(F.lds + hh * LRU_WREG); LAS float* U = XA + 32 * 68;
    const float* cw = A.in[5] + layer * 4 * 512; const float* cbias = A.in[6] + layer * 512;
    const float* ba = A.in[8] + layer * 512; const float* bx = A.in[10] + layer * 512; const float* lam = A.in[11] + layer * 512;
    const bf16* wat = (const bf16*)(A.ws + WS_WAT) + (size_t)(layer * 8 + hh) * 4096; const bf16* wxt = (const bf16*)(A.ws + WS_WXT) + (size_t)(layer * 8 + hh) * 4096;
    float nba0 = 0.f, nba1 = 0.f, nbx0 = 0.f, nbx1 = 0.f, sp0 = 0.f, sp1 = 0.f;
    if constexpr (!FULL) { nba0 = -LOG2E * ba[ch0 + tl]; nba1 = -LOG2E * ba[ch0 + 32 + tl]; nbx0 = -LOG2E * bx[ch0 + tl]; nbx1 = -LOG2E * bx[ch0 + 32 + tl];
        sp0 = -8.f * LOG2E * log1pf(__expf(-lam[ch0 + tl])); sp1 = -8.f * LOG2E * log1pf(__expf(-lam[ch0 + 32 + tl])); }
    float h = 0.f, P = 1.f;
    if (FULL) { const float2* lp = lsum + (size_t)(b * 64) * 512 + ch0 + lane;
#pragma unroll 1
        for (int j0 = 0; j0 < c64; j0 += 16) { float2 sm[16];
#pragma unroll
            for (int i = 0; i < 16; ++i) sm[i] = (j0 + i < c64) ? lp[(size_t)(j0 + i) * 512] : make_float2(1.f, 0.f);
#pragma unroll
            for (int i = 0; i < 16; ++i) h = sm[i].x * h + sm[i].y; } }
#pragma unroll
    for (int tt = 0; tt < 2; ++tt) {
        { LAS unsigned char* LX = (LAS unsigned char*)U;
          LAS float* CW = (LAS float*)(LX + 35 * 144);
#pragma unroll
          for (int it = 0; it < 5; ++it) { const int i = lane + 64 * it; if (i < 35 * 8) { const int row = i >> 3, c = i & 7; const int sp = s0 + 32 * tt - 3 + row;
                v4u v = {0u, 0u, 0u, 0u}; if (sp >= 0) v = *(const GAS v4u*)(proj + (t0 + 32 * tt - 3 + row) * DIN + C_LX + ch0 + 8 * c);
                *(LAS v4u*)(LX + row * 144 + 16 * c) = v; } }
#pragma unroll
          for (int k = 0; k < 4; ++k) CW[k * 64 + lane] = cw[k * 512 + ch0 + lane];
          CW[4 * 64 + lane] = cbias[ch0 + lane];
          LDS_WAIT();
#pragma unroll 1
          for (int ks = 0; ks < 4; ++ks) { const int cb8 = 16 * ks + 8 * hi;
            float a8[8];
            { const f32x4 b0 = *(const LAS f32x4*)(CW + 4 * 64 + cb8), b1 = *(const LAS f32x4*)(CW + 4 * 64 + cb8 + 4); a8[0] = b0.x; a8[1] = b0.y; a8[2] = b0.z; a8[3] = b0.w; a8[4] = b1.x; a8[5] = b1.y; a8[6] = b1.z; a8[7] = b1.w; }
#pragma unroll
            for (int k = 0; k < 4; ++k) { const v4u raw = *(const LAS v4u*)(LX + (tl + 3 - k) * 144 + 2 * cb8);
                const f32x4 w0 = *(const LAS f32x4*)(CW + k * 64 + cb8), w1 = *(const LAS f32x4*)(CW + k * 64 + cb8 + 4);
                a8[0] += w0.x * bflo(raw.x); a8[1] += w0.y * bfhi(raw.x); a8[2] += w0.z * bflo(raw.y); a8[3] += w0.w * bfhi(raw.y);
                a8[4] += w1.x * bflo(raw.z); a8[5] += w1.y * bfhi(raw.z); a8[6] += w1.z * bflo(raw.w); a8[7] += w1.w * bfhi(raw.w); }
            LAS float* xp = XA + tl * 68 + cb8;
            *(LAS f32x4*)xp = (f32x4){a8[0], a8[1], a8[2], a8[3]}; *(LAS f32x4*)(xp + 4) = (f32x4){a8[4], a8[5], a8[6], a8[7]}; } }
        LDS_WAIT();
        bf16x8 af[4];
#pragma unroll
        for (int ks = 0; ks < 4; ++ks) { const LAS float* xp = XA + tl * 68 + 16 * ks + 8 * hi; const f32x4 x0 = *(const LAS f32x4*)xp, x1 = *(const LAS f32x4*)(xp + 4);
            v4u pw; pw.x = pk2(x0.x, x0.y); pw.y = pk2(x0.z, x0.w); pw.z = pk2(x1.x, x1.y); pw.w = pk2(x1.z, x1.w); af[ks] = __builtin_bit_cast(bf16x8, pw); }
        LDS_WAIT();
#pragma unroll 1
        for (int jt = 0; jt < 2; ++jt) { const int j = 32 * jt + tl; f32x16 ra = {}, ia = {};
#pragma unroll
            for (int ks = 0; ks < 4; ++ks) { const bf16x8 bw = *(const GAS bf16x8*)(wat + j * 64 + 16 * ks + 8 * hi), bv = *(const GAS bf16x8*)(wxt + j * 64 + 16 * ks + 8 * hi);
                ra = MFMA32(af[ks], bw, ra); ia = MFMA32(af[ks], bv, ia); }
            float nba_j, nbx_j, sp_j;
            if constexpr (FULL) { nba_j = -LOG2E * ba[ch0 + j]; nbx_j = -LOG2E * bx[ch0 + j]; sp_j = -8.f * LOG2E * log1pf(__expf(-lam[ch0 + j])); }
            else { nba_j = jt ? nba1 : nba0; nbx_j = jt ? nbx1 : nbx0; sp_j = jt ? sp1 : sp0; }
#pragma unroll
            for (int r = 0; r < 16; ++r) { const int tok = (r & 3) + 8 * (r >> 2) + 4 * hi; const float xcv = XA[tok * 68 + j];
                const float rr = __builtin_amdgcn_rcpf(1.f + __builtin_amdgcn_exp2f(__builtin_fmaf(ra[r], -LOG2E, nba_j))), ii = __builtin_amdgcn_rcpf(1.f + __builtin_amdgcn_exp2f(__builtin_fmaf(ia[r], -LOG2E, nbx_j)));
                const float a = __builtin_amdgcn_exp2f(rr * sp_j); const float u = __builtin_amdgcn_sqrtf(fmaxf(1.f - a * a, 0.f)) * ii * xcv;
                XA[tok * 68 + j] = a; U[tok * 68 + j] = u; } }
        LDS_WAIT();
#pragma unroll
        for (int t = 0; t < 32; ++t) { const float a = XA[t * 68 + lane], u = U[t * 68 + lane]; h = a * h + u; P *= a;
            if (FULL) { const float lgv = bf1(proj[(t0 + 32 * tt + t) * DIN + C_LG + ch0 + lane]); y[32 * tt + t] = h * gelu_tanh(lgv); } }
        LDS_WAIT();
    }
    if (!FULL) lsum[(size_t)(b * 64 + c64) * 512 + ch0 + lane] = make_float2(P, h);
}
template <int CTRL> __device__ __forceinline__ float dpp_get(float v) { return __builtin_bit_cast(float, __builtin_amdgcn_update_dpp(0, __builtin_bit_cast(int, v), CTRL, 0xF, 0xF, false)); }
__device__ __forceinline__ float wave_sum_all(float v) {
    v += dpp_get<0xB1>(v); v += dpp_get<0x4E>(v); v += dpp_get<0x141>(v); v += dpp_get<0x140>(v);
    { const auto rr = __builtin_amdgcn_permlane16_swap(__float_as_uint(v), __float_as_uint(v), false, false); v = __uint_as_float(rr[0]) + __uint_as_float(rr[1]); }
    { const auto rr = __builtin_amdgcn_permlane32_swap(__float_as_uint(v), __float_as_uint(v), false, false); v = __uint_as_float(rr[0]) + __uint_as_float(rr[1]); }
    return v;
}
__device__ __forceinline__ float wave_max_all(float v) {
    v = fmaxf(v, dpp_get<0xB1>(v)); v = fmaxf(v, dpp_get<0x4E>(v)); v = fmaxf(v, dpp_get<0x141>(v)); v = fmaxf(v, dpp_get<0x140>(v));
    { const auto rr = __builtin_amdgcn_permlane16_swap(__float_as_uint(v), __float_as_uint(v), false, false); v = fmaxf(__uint_as_float(rr[0]), __uint_as_float(rr[1])); }
    { const auto rr = __builtin_amdgcn_permlane32_swap(__float_as_uint(v), __float_as_uint(v), false, false); v = fmaxf(__uint_as_float(rr[0]), __uint_as_float(rr[1])); }
    return v;
}
__device__ __forceinline__ float row16_sum_all(float v) { v += dpp_get<0xB1>(v); v += dpp_get<0x4E>(v); v += dpp_get<0x141>(v); v += dpp_get<0x140>(v); return v; }
template <int CTRL> __device__ __forceinline__ void wht_dpp_stage(float (&v)[8], bool up) {
#pragma unroll
    for (int i = 0; i < 8; ++i) { const float p = dpp_get<CTRL>(v[i]); v[i] = up ? p - v[i] : v[i] + p; }
}
__device__ __forceinline__ void wht512(float (&v)[8], int lane) {
#pragma unroll
    for (int b = 0; b < 3; ++b)
#pragma unroll
        for (int i = 0; i < 8; ++i) if (!(i & (1 << b))) { const float a = v[i], c = v[i | (1 << b)]; v[i] = a + c; v[i | (1 << b)] = a - c; }
    wht_dpp_stage<0xB1>(v, lane & 1); wht_dpp_stage<0x4E>(v, lane & 2); wht_dpp_stage<0x141>(v, lane & 4); wht_dpp_stage<0x140>(v, lane & 8);
    { const float s16 = (lane & 16) ? -1.f : 1.f;
#pragma unroll
      for (int i = 0; i < 8; ++i) { const auto rr = __builtin_amdgcn_permlane16_swap(__float_as_uint(v[i]), __float_as_uint(v[i]), false, false); v[i] = __uint_as_float(rr[0]) + s16 * __uint_as_float(rr[1]); } }
    { const float s32 = (lane & 32) ? -0.04419417382415922f : 0.04419417382415922f;
#pragma unroll
      for (int i = 0; i < 8; ++i) { const auto rr = __builtin_amdgcn_permlane32_swap(__float_as_uint(v[i]), __float_as_uint(v[i]), false, false); v[i] = 0.04419417382415922f * __uint_as_float(rr[0]) + s32 * __uint_as_float(rr[1]); } }
}
__device__ __forceinline__ void mix_unit(const Args& A, const Frame& F, int unit, int layer, const bf16* proj, const bf16* amixb, signed char* amix8, float* asm_o, const float* ssqa, float2* lsum) {
    float y[64];
    lru_chunk<true>(A, F, unit, layer, proj, lsum, y);
    { LAS float* Yw = (LAS float*)(F.lds + F.wave * LRU_WREG);
#pragma unroll
      for (int t = 0; t < 64; ++t) Yw[t * 68 + F.lane] = y[t]; }
    __syncthreads();
    const int b = unit >> 6, c64 = unit & 63, lane = F.lane, s0 = c64 * 64; const size_t t0 = (size_t)b * SEQ + s0;
    const float* cwp = A.in[4] + layer * 3 * 512 + lane * 8;
    float w0[8], w1[8], w2[8];
    { const f32x4 a0 = *(const GAS f32x4*)(cwp), a1 = *(const GAS f32x4*)(cwp + 4), b0 = *(const GAS f32x4*)(cwp + 512), b1 = *(const GAS f32x4*)(cwp + 516), c0 = *(const GAS f32x4*)(cwp + 1024), c1 = *(const GAS f32x4*)(cwp + 1028);
      w0[0] = a0.x; w0[1] = a0.y; w0[2] = a0.z; w0[3] = a0.w; w0[4] = a1.x; w0[5] = a1.y; w0[6] = a1.z; w0[7] = a1.w;
      w1[0] = b0.x; w1[1] = b0.y; w1[2] = b0.z; w1[3] = b0.w; w1[4] = b1.x; w1[5] = b1.y; w1[6] = b1.z; w1[7] = b1.w;
      w2[0] = c0.x; w2[1] = c0.y; w2[2] = c0.z; w2[3] = c0.w; w2[4] = c1.x; w2[5] = c1.y; w2[6] = c1.z; w2[7] = c1.w; }
    float p0[8], p1[8], p2[8];
#pragma unroll
    for (int j = 0; j < 8; ++j) { p0[j] = 0.f; p1[j] = 0.f; p2[j] = 0.f; }
#pragma unroll 2
    for (int i = -2; i < 8; ++i) { const int tok = 8 * F.wave + i; const size_t t = t0 + tok;
#pragma unroll
        for (int j = 0; j < 8; ++j) { p2[j] = p1[j]; p1[j] = p0[j]; p0[j] = 0.f; }
        if (s0 + tok >= 0) { const bf16* rp = proj + t * DIN; const v4u cc = *(const GAS v4u*)(rp + C_CC + lane * 8), cx = *(const GAS v4u*)(rp + C_CX + lane * 8);
            p0[0] = bflo(cc.x) * bflo(cx.x); p0[1] = bfhi(cc.x) * bfhi(cx.x); p0[2] = bflo(cc.y) * bflo(cx.y); p0[3] = bfhi(cc.y) * bfhi(cx.y);
            p0[4] = bflo(cc.z) * bflo(cx.z); p0[5] = bfhi(cc.z) * bfhi(cx.z); p0[6] = bflo(cc.w) * bflo(cx.w); p0[7] = bfhi(cc.w) * bfhi(cx.w); }
        if (i >= 0) {
            const v4u cbv = *(const GAS v4u*)(proj + t * DIN + C_CB + lane * 8);
            float yc[8]; const float cbf[8] = {bflo(cbv.x), bfhi(cbv.x), bflo(cbv.y), bfhi(cbv.y), bflo(cbv.z), bfhi(cbv.z), bflo(cbv.w), bfhi(cbv.w)};
            float qc = 0.f;
#pragma unroll
            for (int j = 0; j < 8; ++j) { yc[j] = cbf[j] * (w0[j] * p0[j] + w1[j] * p1[j] + w2[j] * p2[j]); qc += yc[j] * yc[j]; }
            const LAS float* yr = (const LAS float*)(F.lds + (lane >> 3) * LRU_WREG) + tok * 68 + (lane & 7) * 8;
            const f32x4 y0 = *(const LAS f32x4*)yr, y1 = *(const LAS f32x4*)(yr + 4);
            float ql = (y0.x * y0.x + y0.y * y0.y) + (y0.z * y0.z + y0.w * y0.w) + (y1.x * y1.x + y1.y * y1.y) + (y1.z * y1.z + y1.w * y1.w);
            qc = wave_sum_all(qc); ql = wave_sum_all(ql);
            const float sa = row16_sum_all(ssqa[t * 16 + (lane & 15)]);
            const float ra_inv = sqrtf(sa * (1.f / 1024.f) + EPS);
            const float fc = rsqrtf(qc * (1.f / 512.f) + EPS) * ra_inv, fl = rsqrtf(ql * (1.f / 512.f) + EPS) * ra_inv;
            float yl[8] = {y0.x * fl, y0.y * fl, y0.z * fl, y0.w * fl, y1.x * fl, y1.y * fl, y1.z * fl, y1.w * fl};
#pragma unroll
            for (int j = 0; j < 8; ++j) yc[j] *= fc;
            wht512(yc, lane); wht512(yl, lane);
            const v4u at0 = *(const GAS v4u*)(amixb + t * 1024 + lane * 8), at1 = *(const GAS v4u*)(amixb + t * 1024 + 512 + lane * 8);
            const unsigned aw[8] = {at0.x, at0.y, at0.z, at0.w, at1.x, at1.y, at1.z, at1.w};
            float mx = 0.f;
#pragma unroll
            for (int j = 0; j < 8; ++j) { mx = fmaxf(mx, fmaxf(fabsf(yc[j]), fabsf(yl[j]))); mx = fmaxf(mx, fmaxf(fabsf(bflo(aw[j])), fabsf(bfhi(aw[j])))); }
            mx = wave_max_all(mx);
            mx = fmaxf(mx, 1e-30f); const float inv = 127.f / mx;
            unsigned qa[4], qc2[2], ql2[2];
#pragma unroll
            for (int j = 0; j < 4; ++j) { const int a0 = (int)__builtin_rintf(bflo(aw[2 * j]) * inv), a1 = (int)__builtin_rintf(bfhi(aw[2 * j]) * inv), a2 = (int)__builtin_rintf(bflo(aw[2 * j + 1]) * inv), a3 = (int)__builtin_rintf(bfhi(aw[2 * j + 1]) * inv);
                qa[j] = ((unsigned)a0 & 255u) | (((unsigned)a1 & 255u) << 8) | (((unsigned)a2 & 255u) << 16) | ((unsigned)a3 << 24); }
#pragma unroll
            for (int j = 0; j < 2; ++j) { const int c0 = (int)__builtin_rintf(yc[4 * j] * inv), c1 = (int)__builtin_rintf(yc[4 * j + 1] * inv), c2 = (int)__builtin_rintf(yc[4 * j + 2] * inv), c3 = (int)__builtin_rintf(yc[4 * j + 3] * inv);
                qc2[j] = ((unsigned)c0 & 255u) | (((unsigned)c1 & 255u) << 8) | (((unsigned)c2 & 255u) << 16) | ((unsigned)c3 << 24);
                const int l0 = (int)__builtin_rintf(yl[4 * j] * inv), l1 = (int)__builtin_rintf(yl[4 * j + 1] * inv), l2 = (int)__builtin_rintf(yl[4 * j + 2] * inv), l3 = (int)__builtin_rintf(yl[4 * j + 3] * inv);
                ql2[j] = ((unsigned)l0 & 255u) | (((unsigned)l1 & 255u) << 8) | (((unsigned)l2 & 255u) << 16) | ((unsigned)l3 << 24); }
            GAS v2u* orow = (GAS v2u*)(amix8 + t * D);
            orow[lane] = (v2u){qa[0], qa[1]}; orow[64 + lane] = (v2u){qa[2], qa[3]}; orow[128 + lane] = (v2u){qc2[0], qc2[1]}; orow[192 + lane] = (v2u){ql2[0], ql2[1]};
            if (lane == 0) asm_o[t] = mx * (1.f / 127.f) / ra_inv;
        }
    }
    __syncthreads();
}
template <int CTRL, int RM> __device__ __forceinline__ float dppf(float v) { return __builtin_bit_cast(float, __builtin_amdgcn_update_dpp(0, __builtin_bit_cast(int, v), CTRL, RM, 0xF, false)); }
__device__ __forceinline__ float wave_sum63(float v) { v += dppf<0xB1, 0xF>(v); v += dppf<0x4E, 0xF>(v); v += dppf<0x141, 0xF>(v); v += dppf<0x140, 0xF>(v); v += dppf<0x142, 0xA>(v); v += dppf<0x143, 0xC>(v); return v; }
__device__ __forceinline__ float wave_max63(float v) { v = fmaxf(v, dppf<0xB1, 0xF>(v)); v = fmaxf(v, dppf<0x4E, 0xF>(v)); v = fmaxf(v, dppf<0x141, 0xF>(v)); v = fmaxf(v, dppf<0x140, 0xF>(v)); v = fmaxf(v, dppf<0x142, 0xA>(v)); v = fmaxf(v, dppf<0x143, 0xC>(v)); return v; }
__device__ __forceinline__ void router_phase(const Args& A, const Frame& F, const bf16* xa) {
    unsigned char* ws = A.ws;
    const int lane = F.lane, w = F.wave;
    LAS float* RWL = (LAS float*)F.lds;
    LAS float* invs = (LAS float*)(F.lds + 65536);
    LAS unsigned* eblk = (LAS unsigned*)(F.lds + 65536 + 256);
    const float* gn = A.in[14] + D; const float* rw = A.in[18];
    float* as_o = (float*)(ws + WS_AS); signed char* xq = (signed char*)(ws + WS_XQ8); unsigned* toke = (unsigned*)(ws + WS_TOKE); float* tokw = (float*)(ws + WS_TOKW); unsigned* lrank = (unsigned*)(ws + WS_LRANK); int* blkcnt = (int*)(ws + WS_BLKCNT);
#pragma unroll
    for (int m = 0; m < 4; ++m) { const int k = F.tid + 512 * m; const float g = gn[k]; const f32x4 a = *(const GAS f32x4*)(rw + k * 8), b = *(const GAS f32x4*)(rw + k * 8 + 4);
        LAS float* p = RWL + (((k >> 9) * 8 + (k & 7)) * 64 + ((k >> 3) & 63)) * 8; *(LAS f32x4*)p = a * g; *(LAS f32x4*)(p + 4) = b * g; }
    __syncthreads();
    for (int blk = blockIdx.x; blk < T / 64; blk += F.G) {
#pragma unroll 1
        for (int i = 0; i < 8; ++i) { const int tl = 8 * w + i; const size_t t = (size_t)blk * 64 + tl;
            const GAS v4u* xr = (const GAS v4u*)(xa + t * D) + lane; v4u v[4];
#pragma unroll
            for (int j = 0; j < 4; ++j) v[j] = xr[64 * j];
            float acc[8], q = 0.f, mx = 0.f;
#pragma unroll
            for (int e = 0; e < 8; ++e) acc[e] = 0.f;
#pragma unroll
            for (int j = 0; j < 4; ++j) { const unsigned ww[4] = {v[j].x, v[j].y, v[j].z, v[j].w};
#pragma unroll
                for (int i8 = 0; i8 < 8; ++i8) { const float x = (i8 & 1) ? bfhi(ww[i8 >> 1]) : bflo(ww[i8 >> 1]);
                    const LAS float* p = RWL + ((j * 8 + i8) * 64 + lane) * 8; const f32x4 r0 = *(const LAS f32x4*)p, r1 = *(const LAS f32x4*)(p + 4);
                    acc[0] += x * r0.x; acc[1] += x * r0.y; acc[2] += x * r0.z; acc[3] += x * r0.w; acc[4] += x * r1.x; acc[5] += x * r1.y; acc[6] += x * r1.z; acc[7] += x * r1.w;
                    q += x * x; mx = fmaxf(mx, fabsf(x)); } }
#pragma unroll
            for (int e = 0; e < 8; ++e) acc[e] = wave_sum63(acc[e]);
            q = wave_sum63(q); mx = wave_max63(mx);
            if (lane == 63) { mx = fmaxf(mx, 1e-30f);
                const float rs = rsqrtf(q * (1.f / D) + EPS);
                int e1 = 0; float l1 = acc[0];
#pragma unroll
                for (int e = 1; e < 8; ++e) if (acc[e] > l1) { l1 = acc[e]; e1 = e; }
                int e2 = -1; float l2 = -__builtin_inff();
#pragma unroll
                for (int e = 0; e < 8; ++e) if (e != e1 && acc[e] > l2) { l2 = acc[e]; e2 = e; }
                const float w1 = 1.f / (1.f + expf((l2 - l1) * rs)), w2 = 1.f - w1;
                as_o[t] = mx * (1.f / 127.f) * rs; toke[t] = (unsigned)e1 | ((unsigned)e2 << 8); tokw[2 * t] = w1; tokw[2 * t + 1] = w2; eblk[tl] = (unsigned)e1 | ((unsigned)e2 << 8); invs[tl] = 127.f / mx; }
            LDS_WAIT();
            const float inv = invs[tl];
            GAS v2u* o8 = (GAS v2u*)(xq + t * D) + lane;
#pragma unroll
            for (int j = 0; j < 4; ++j) { const unsigned ww[4] = {v[j].x, v[j].y, v[j].z, v[j].w}; unsigned o[2];
#pragma unroll
                for (int h2 = 0; h2 < 2; ++h2) { const int a0 = (int)__builtin_rintf(bflo(ww[2 * h2]) * inv), a1 = (int)__builtin_rintf(bfhi(ww[2 * h2]) * inv), a2 = (int)__builtin_rintf(bflo(ww[2 * h2 + 1]) * inv), a3 = (int)__builtin_rintf(bfhi(ww[2 * h2 + 1]) * inv);
                    o[h2] = ((unsigned)a0 & 255u) | (((unsigned)a1 & 255u) << 8) | (((unsigned)a2 & 255u) << 16) | ((unsigned)a3 << 24); }
                o8[64 * j] = (v2u){o[0], o[1]}; }
        }
        __syncthreads();
        if (F.wave == 0) { const unsigned ev = eblk[lane]; const int e1 = ev & 255u, e2 = ev >> 8; const unsigned long long lower = (1ull << lane) - 1ull; unsigned r0 = 0, r1 = 0; int mycnt = 0;
#pragma unroll
            for (int e = 0; e < 8; ++e) { const unsigned long long m = __ballot(e1 == e) | __ballot(e2 == e); const int cnt = __popcll(m);
                if (e1 == e) r0 = (unsigned)__popcll(m & lower); if (e2 == e) r1 = (unsigned)__popcll(m & lower); if (lane == e) mycnt = cnt; }
            if (lane < 8) blkcnt[blk * 8 + lane] = mycnt;
            lrank[(size_t)blk * 64 + lane] = r0 | (r1 << 16); }
        __syncthreads();
    }
}
__device__ __forceinline__ void gather_phase(const Args& A, const Frame& F) {
    unsigned char* ws = A.ws;
    const float* as_i = (const float*)(ws + WS_AS); const unsigned* toke = (const unsigned*)(ws + WS_TOKE); const float* tokw = (const float*)(ws + WS_TOKW); const unsigned* lrank = (const unsigned*)(ws + WS_LRANK);
    const int* blkcnt = (const int*)(ws + WS_BLKCNT); int* seg = (int*)(ws + WS_SEG); int* pos_o = (int*)(ws + WS_POS); float* ass = (float*)(ws + WS_ASS); float* gws = (float*)(ws + WS_GWS);
    const signed char* xq = (const signed char*)(ws + WS_XQ8); signed char* xp = (signed char*)(ws + WS_XP);
    LAS int* sh = (LAS int*)F.lds;
    const int lane = F.lane;
    for (int blk = blockIdx.x; blk < T / 64; blk += F.G) {
        { const int e = F.wave; int tot = 0, pre = 0;
#pragma unroll
          for (int j = 0; j < 4; ++j) { const int idx = lane + 64 * j; const int c = blkcnt[idx * 8 + e]; tot += c; pre += (idx < blk) ? c : 0; }
          tot = wave_sum_i(tot); pre = wave_sum_i(pre);
          if (lane == 0) { sh[e] = tot; sh[8 + e] = pre; } }
        __syncthreads();
        if (F.tid == 0) { int s = 0;
            for (int e = 0; e < 8; ++e) { sh[16 + e] = s; s += (sh[e] + 255) & ~255; }
            sh[24] = s;
            if (blk == 0) { for (int e = 0; e < 9; ++e) seg[e] = sh[16 + e]; } }
        __syncthreads();
#pragma unroll 1
        for (int pi = F.wave * 16; pi < F.wave * 16 + 16; ++pi) { const int tl = pi >> 1, s = pi & 1; const size_t t = (size_t)blk * 64 + tl;
            const unsigned ev = toke[t], lr = lrank[t]; const int e = s ? (int)(ev >> 8) : (int)(ev & 255u); const int rank = s ? (int)(lr >> 16) : (int)(lr & 0xffffu);
            const int pos = sh[16 + e] + sh[8 + e] + rank;
            if (lane == 0) { pos_o[2 * t + s] = pos; ass[pos] = as_i[t]; gws[pos] = tokw[2 * t + s]; }
            const GAS v4u* src = (const GAS v4u*)(xq + t * D) + lane; GAS v4u* dst = (GAS v4u*)(xp + (size_t)pos * D) + lane;
#pragma unroll
            for (int j = 0; j < 2; ++j) dst[64 * j] = src[64 * j]; }
        __syncthreads();
    }
}
__device__ __forceinline__ void final_phase(const Args& A, const Frame& F, const bf16* xa, float* out) {
    const int gw = blockIdx.x * NWAVES + F.wave, NGW = F.G * NWAVES, lane = F.lane;
    const int* pos = (const int*)(A.ws + WS_POS); const bf16* Y = (const bf16*)(A.ws + WS_Y); const float* gf = A.in[22];
    for (int t = gw; t < T; t += NGW) { const int p0 = pos[2 * t], p1 = pos[2 * t + 1];
        const GAS v2u* xr = (const GAS v2u*)(xa + (size_t)t * D) + lane; const GAS v2u* y0 = (const GAS v2u*)(Y + (size_t)p0 * D) + lane; const GAS v2u* y1 = (const GAS v2u*)(Y + (size_t)p1 * D) + lane;
        GAS f32x4* orow = (GAS f32x4*)(out + (size_t)t * D) + lane;
        f32x4 v[8]; float q = 0.f;
#pragma unroll
        for (int j = 0; j < 8; ++j) { const v2u x = xr[64 * j], a = y0[64 * j], b = y1[64 * j];
            v[j].x = bflo(x.x) + bflo(a.x) + bflo(b.x); v[j].y = bfhi(x.x) + bfhi(a.x) + bfhi(b.x); v[j].z = bflo(x.y) + bflo(a.y) + bflo(b.y); v[j].w = bfhi(x.y) + bfhi(a.y) + bfhi(b.y);
            q += (v[j].x * v[j].x + v[j].y * v[j].y) + (v[j].z * v[j].z + v[j].w * v[j].w); }
        q = wave_sum(q); const float rs = rsqrtf(q * (1.f / D) + EPS);
#pragma unroll
        for (int j = 0; j < 8; ++j) { const f32x4 g = *((const GAS f32x4*)gf + lane + 64 * j); orow[64 * j] = v[j] * rs * g; }
    }
}

#ifndef REP_P0
#define REP_P0 1
#endif
#ifndef REP_T
#define REP_T 1
#endif
#ifndef REP_G
#define REP_G 1
#endif
__global__ void __launch_bounds__(NWAVES * 64, 2) hy_fwd(Args args) {
    extern __shared__ __attribute__((aligned(16))) unsigned char lds[];
    Frame F;
    F.lds = (LAS unsigned char*)lds;
    F.tid = threadIdx.x; F.lane = F.tid & 63; F.wave = __builtin_amdgcn_readfirstlane(F.tid >> 6); F.G = gridDim.x;
#define FRESH() do { int t_ = threadIdx.x; asm volatile("" : "+v"(t_)); F.tid = t_; F.lane = t_ & 63; F.wave = __builtin_amdgcn_readfirstlane(t_ >> 6); } while (0)
    unsigned char* ws = args.ws;
    for (int u = F.tid; u < (LDS_BYTES - LDSCTL_OFF) / 4; u += NWAVES * 64) ((LAS unsigned*)(F.lds + LDSCTL_OFF))[u] = 0u;
    __syncthreads();
    XcdBarrier bar; bar.bar = (unsigned*)(ws + WS_CTL) + CW_BAR; bar.x = 0; bar.st = nullptr;
#if !MK_PER_PHASE
    bar = xcd_barrier_post((unsigned*)(ws + WS_CTL) + CW_BAR, (volatile LAS unsigned*)(F.lds + MISC_OFF) + 8);
#endif
    const int lo = args.ph_lo, hi = args.ph_hi;
#define IN(k) (lo <= (k) && (k) < hi)
#if MK_PER_PHASE
#define SEAM(k) do { } while (0)
#else
#define SEAM(k) do { if (IN(k) && IN((k) + 1)) xcd_barrier(bar); } while (0)
#endif
    bf16* const PROJ = (bf16*)(ws + WS_PROJ); bf16* const AMIXB = (bf16*)(ws + WS_AMIXB); signed char* const AMIX8 = (signed char*)(ws + WS_AMIX8);
    float* const SSQA = (float*)(ws + WS_SSQA); float2* const LSUM = (float2*)(ws + WS_LSUM);
    const unsigned* const CM = (const unsigned*)(ws + WS_CMAX);
    bf16* const XA = (bf16*)(ws + WS_XA);
    bf16* const XB = (bf16*)(ws + WS_XB);

    if (IN(0)) { FRESH(); for (int rep = 0; rep < REP_P0; ++rep) p0_prologue(args, F); } SEAM(0);

#pragma unroll 1
    for (int l = 0; l < 2; ++l) {
        const int pb = 1 + 9 * l;
        if (IN(pb)) {
            pg8::Gemm g{(const bf16*)(ws + WS_XQ8), (const bf16*)(ws + WS_WIN + (size_t)l * DIN * D), T, DIN, D / 2}; pg8::GroupOrder S; S.init(T / 256, DIN, F.G, (int)blockIdx.x);
            pg8::EpiScaleBf16I8P E{PROJ, DIN, (const float*)(ws + WS_AS), CM + CM_IN + l * DIN, 0};
            for (int rep = 0; rep < REP_G; ++rep) pg8::gemm_phase<pg8::EpiScaleBf16I8P, pg8::GroupOrder, PG8_ALIGN, PG8_SP2>(F.lds, g, S, E);
            if (l == 0) { FRESH(); wout_quant(args, F); }
        } SEAM(pb);
        if (IN(pb + 1)) { FRESH();
            for (int rep = 0; rep < REP_T; ++rep) {
            for (int u = blockIdx.x; u < 256; u += F.G) attn_unit(F, u, PROJ, AMIXB, SSQA, args.in[3] + l * 16);
            for (int u = blockIdx.x; u < 256; u += F.G) { float dummy[64]; lru_chunk<false>(args, F, u, l, PROJ, LSUM, dummy); }
            __syncthreads(); }
        } SEAM(pb + 1);
        if (IN(pb + 2)) { FRESH();
            for (int rep = 0; rep < REP_T; ++rep) for (int u = blockIdx.x; u < 256; u += F.G) mix_unit(args, F, u, l, PROJ, AMIXB, AMIX8, (float*)(ws + WS_ASM), SSQA, LSUM);
        } SEAM(pb + 2);
        if (IN(pb + 3)) {
            pg8::Gemm g{(const bf16*)AMIX8, (const bf16*)(ws + WS_WOUT + (size_t)l * D * D), T, D, D / 2}; pg8::GroupOrder S; S.init(T / 256, D, F.G, (int)blockIdx.x);
            pg8::EpiResidI8P E{XB, XA, (const float*)(ws + WS_ASM), CM + CM_OUT + l * D};
            for (int rep = 0; rep < REP_G; ++rep) pg8::gemm_phase<pg8::EpiResidI8P, pg8::GroupOrder, PG8_ALIGN, PG8_SP2>(F.lds, g, S, E);
        } SEAM(pb + 3);
        if (l == 0) {
            if (IN(5)) { FRESH(); for (int rep = 0; rep < REP_T; ++rep) rowquant16_phase(args, F, XA); } SEAM(5);
            if (IN(6)) {
                pg8::Gemm g{(const bf16*)(ws + WS_XQ8), (const bf16*)(ws + WS_WGU), T, 2 * DFF, D / 2}; pg8::GroupOrder S; S.init(T / 256, 2 * DFF, F.G, (int)blockIdx.x);
                pg8::EpiSwigluI8P E{(bf16*)(ws + WS_ACT), DFF, (const float*)(ws + WS_AS), CM + CM_GU, 0};
                for (int rep = 0; rep < REP_G; ++rep) pg8::gemm_phase<pg8::EpiSwigluI8P, pg8::GroupOrder, PG8_ALIGN, PG8_SP2>(F.lds, g, S, E);
            } SEAM(6);
            if (IN(7)) { FRESH(); for (int rep = 0; rep < REP_T; ++rep) actquant_phase<DFF, 8>(F, (const bf16*)(ws + WS_ACT), (signed char*)(ws + WS_ACT8), (float*)(ws + WS_ASD), nullptr, T); } SEAM(7);
            if (IN(8)) {
                pg8::Gemm g{(const bf16*)(ws + WS_ACT8), (const bf16*)(ws + WS_WD), T, D, DFF / 2}; pg8::GroupOrder S; S.init(T / 256, D, F.G, (int)blockIdx.x);
                pg8::EpiResidI8P E{XA, XB, (const float*)(ws + WS_ASD), CM + CM_D};
                for (int rep = 0; rep < REP_G; ++rep) pg8::gemm_phase<pg8::EpiResidI8P, pg8::GroupOrder, PG8_ALIGN, PG8_SP2>(F.lds, g, S, E);
            } SEAM(8);
            if (IN(9)) { FRESH(); for (int rep = 0; rep < REP_T; ++rep) rowquant16_phase(args, F, XB); } SEAM(9);
        } else {
            if (IN(14)) { FRESH(); for (int rep = 0; rep < REP_T; ++rep) router_phase(args, F, XA); } SEAM(14);
            if (IN(15)) { FRESH(); for (int rep = 0; rep < REP_T; ++rep) gather_phase(args, F); } SEAM(15);
            if (IN(16)) {
                const int* seg = (const int*)(ws + WS_SEG);
                pg8::GroupOrder S; S.init(seg[8] >> 8, 2 * DE, F.G, (int)blockIdx.x); S.estride = (size_t)2 * DE * D;
#pragma unroll
                for (int e = 0; e < 9; ++e) S.pstart[e] = seg[e] >> 8;
                pg8::Gemm g{(const bf16*)(ws + WS_XP), (const bf16*)(ws + WS_EGU), MROWS, 2 * DE, D / 2};
                pg8::EpiSwigluI8P E{(bf16*)(ws + WS_ACTM), DE, (const float*)(ws + WS_ASS), CM + CM_EGU, 2 * DE};
                for (int rep = 0; rep < REP_G; ++rep) pg8::gemm_phase<pg8::EpiSwigluI8P, pg8::GroupOrder, PG8_ALIGN, PG8_SP2>(F.lds, g, S, E);
            } SEAM(16);
            if (IN(17)) { FRESH(); const int nrows = ((const int*)(ws + WS_SEG))[8];
                for (int rep = 0; rep < REP_T; ++rep) actquant_phase<DE, 4>(F, (const bf16*)(ws + WS_ACTM), (signed char*)(ws + WS_ACTM8), (float*)(ws + WS_ASDM), (const float*)(ws + WS_GWS), nrows); } SEAM(17);
            if (IN(18)) {
                const int* seg = (const int*)(ws + WS_SEG);
                pg8::GroupOrder S; S.init(seg[8] >> 8, D, F.G, (int)blockIdx.x); S.estride = (size_t)D * DE;
#pragma unroll
                for (int e = 0; e < 9; ++e) S.pstart[e] = seg[e] >> 8;
                pg8::Gemm g{(const bf16*)(ws + WS_ACTM8), (const bf16*)(ws + WS_ED), MROWS, D, DE / 2};
                pg8::EpiScaleBf16I8P E{(bf16*)(ws + WS_Y), D, (const float*)(ws + WS_ASDM), CM + CM_ED, D};
                for (int rep = 0; rep < REP_G; ++rep) pg8::gemm_phase<pg8::EpiScaleBf16I8P, pg8::GroupOrder, PG8_ALIGN, PG8_SP2>(F.lds, g, S, E);
            } SEAM(18);
            if (IN(19)) { FRESH(); final_phase(args, F, XA, args.out); }
        }
    }
#undef IN
#undef SEAM
}

extern "C" void kernel_launch(void* const* d_in, const int* in_sizes, int n_in, void* d_out, int out_size, void* d_ws, size_t ws_size, hipStream_t stream) {
    static int grid = 0;
    if (grid == 0) {
        if (n_in != 23 || in_sizes[0] != T * D || out_size != T * D || ws_size < WS_END) { fprintf(stderr, "kernel_launch: unexpected shapes / workspace (%d inputs, ws %zu, need %zu)\n", n_in, ws_size, (size_t)WS_END); grid = -1; return; }
        int dev = 0, cus = 0;
        if (hipGetDevice(&dev) != hipSuccess || hipDeviceGetAttribute(&cus, hipDeviceAttributeMultiprocessorCount, dev) != hipSuccess) { grid = -1; return; }
        if (hipFuncSetAttribute((const void*)hy_fwd, hipFuncAttributeMaxDynamicSharedMemorySize, LDS_BYTES) != hipSuccess) { fprintf(stderr, "kernel_launch: hipFuncSetAttribute failed\n"); grid = -1; return; }
        int per_cu = 0;
        if (hipOccupancyMaxActiveBlocksPerMultiprocessor(&per_cu, (const void*)hy_fwd, NWAVES * 64, LDS_BYTES) != hipSuccess || per_cu < 1) fprintf(stderr, "kernel_launch: occupancy query reports %d\n", per_cu);
        (void)hipGetLastError();
        grid = cus;
    }
    if (grid < 0) return;
    if (hipMemsetAsync((char*)d_ws + WS_CTL, 0, CTL_ZERO_BYTES, stream) != hipSuccess) return;
    Args a{};
    for (int i = 0; i < 23; ++i) a.in[i] = (const float*)d_in[i];
    a.out = (float*)d_out; a.ws = (unsigned char*)d_ws;
#if MK_PER_PHASE
    for (int ph = 0; ph < N_PHASES; ++ph) { a.ph_lo = ph; a.ph_hi = ph + 1; hipLaunchKernelGGL(hy_fwd, dim3(grid), dim3(NWAVES * 64), LDS_BYTES, stream, a); }
#else
    a.ph_lo = 0; a.ph_hi = N_PHASES; hipLaunchKernelGGL(hy_fwd, dim3(grid), dim3(NWAVES * 64), LDS_BYTES, stream, a);
#endif
}
```

```cpp
#include <hip/hip_runtime.h>
#include <cstdio>
#include <cstdint>
#ifndef MK_PER_PHASE
#define MK_PER_PHASE 0
#endif
namespace pg8 {
#define PG8_LAS __attribute__((address_space(3)))
typedef unsigned short bf16_t;
typedef short bf16x8 __attribute__((ext_vector_type(8)));
typedef float f32x4 __attribute__((ext_vector_type(4)));
typedef unsigned u32x4 __attribute__((ext_vector_type(4)));
typedef int i32x4 __attribute__((ext_vector_type(4)));
constexpr int BM = 256, BK = 64, HALF = 128, HTB = HALF * BK * 2  , STAGE_BYTES = 8 * HTB, NXCD = 8, WGM = 6, WGM_N8 = 3;

__host__ __device__ __forceinline__ int lds_byte(int r, int c) { const int st = (r >> 4) * 2 + (c >> 5), rr = r & 15, cc = c & 31, ob = rr * 64 + cc * 2; return st * 1024 + (ob ^ (((ob >> 9) & 1) << 5)); }
__host__ __device__ __forceinline__ void stage_rc(int b, int& R, int& C) { const int st = b / 1024, sb = b % 1024, swz = sb ^ (((sb >> 9) & 1) << 5); R = (st >> 1) * 16 + swz / 64; C = (st & 1) * 32 + (swz % 64) / 2; }
__host__ __device__ __forceinline__ int perm32(int rho) { const int n = rho >> 4, i = rho & 15; return 8 * (i >> 2) + 4 * n + (i & 3); }

struct Unit { int pm, pn, eid; size_t bofs; };
struct Gemm { const bf16_t* A; const bf16_t* Bt; int M, N, K; };

struct GroupOrder {
    int nM, nN, nwg, G, c, wgm; int pstart[9]; size_t estride;
    __device__ void init(int nM_, int N, int G_, int c_) { nM = nM_; nN = N / BM; nwg = nM * nN; G = G_; c = c_; estride = 0; wgm = (nN == 8) ? WGM_N8 : WGM;
#pragma unroll
        for (int e = 0; e < 9; ++e) pstart[e] = (e == 0) ? 0 : nM_; }
    __device__ bool next(int i, Unit& u) const {
        const long L = (long)i * G + c; if (L >= nwg) return false;
        int wgid = (int)L; { const int q = nwg / NXCD, r = nwg % NXCD, xcd = wgid % NXCD, off = wgid / NXCD; wgid = (xcd < r ? xcd * (q + 1) : r * (q + 1) + (xcd - r) * q) + off; }
        const int nig = wgm * nN, gid = wgid / nig, fm = gid * wgm, gsz = (nM - fm) < wgm ? (nM - fm) : wgm;
        u.pm = fm + ((wgid % nig) % gsz); u.pn = (wgid % nig) / gsz;
        int e = 0;
#pragma unroll
        for (int k = 1; k < 8; ++k) e += (u.pm >= pstart[k]) ? 1 : 0;
        u.eid = e; u.bofs = (size_t)e * estride; return true;
    }
    __device__ __forceinline__ void a_ready(const Unit&) const {}
    __device__ __forceinline__ void done(const Unit&) const {}
};

typedef float f32x2 __attribute__((ext_vector_type(2))); typedef __bf16 bf16x2_t __attribute__((ext_vector_type(2)));
__device__ __forceinline__ unsigned cvt_pk_bf16(float lo, float hi) { f32x2 v = {lo, hi}; bf16x2_t b = __builtin_convertvector(v, bf16x2_t); return __builtin_bit_cast(unsigned, b); }
__device__ __forceinline__ float silu_mul(float g, float u) { return g * u * __builtin_amdgcn_rcpf(1.f + __builtin_amdgcn_exp2f(-1.4426950408889634f * g)); }
struct EpiScaleBf16I8 {
    static constexpr bool PERM = true, AFTER_DRAIN = false, I8 = true, PREF = false; typedef i32x4 acc_t;
    bf16_t* O; int ldc; const float* rs; const unsigned* cmax; int ncol;
    __device__ __forceinline__ void operator()(const i32x4 (&acc)[2][2][4][2], const Unit& u, int wr, int wc, int fr, int fq) const {
        const int row0 = u.pm * BM + wr * 64 + fr, col0 = u.pn * BM + wc * 32 + 8 * fq;
        const unsigned* cm = cmax + (size_t)u.eid * ncol + col0;
        f32x4 sc[2][2];
#pragma unroll
        for (int bj = 0; bj < 2; ++bj)
#pragma unroll
            for (int n = 0; n < 2; ++n) sc[bj][n] = __builtin_bit_cast(f32x4, *(const u32x4*)(cm + bj * HALF + 4 * n)) * (1.f / 127.f);
#pragma unroll
        for (int ai = 0; ai < 2; ++ai)
#pragma unroll
            for (int m = 0; m < 4; ++m) { const int r = row0 + ai * HALF + m * 16; const float sa = rs[r]; bf16_t* rowp = O + (size_t)r * ldc + col0;
#pragma unroll
                for (int bj = 0; bj < 2; ++bj) { const f32x4 v0 = __builtin_convertvector(acc[ai][bj][m][0], f32x4) * (sc[bj][0] * sa), v1 = __builtin_convertvector(acc[ai][bj][m][1], f32x4) * (sc[bj][1] * sa);
                    u32x4 w; w.x = cvt_pk_bf16(v0[0], v0[1]); w.y = cvt_pk_bf16(v0[2], v0[3]); w.z = cvt_pk_bf16(v1[0], v1[1]); w.w = cvt_pk_bf16(v1[2], v1[3]);
                    *(u32x4*)(rowp + bj * HALF) = w; } }
    }
};
__device__ __forceinline__ void ld_base8i(const float* base32, const bf16_t* base16, size_t off, f32x4& b0, f32x4& b1) {
    if (base32) { b0 = *(const f32x4*)(base32 + off); b1 = *(const f32x4*)(base32 + off + 4); }
    else { const u32x4 w = *(const u32x4*)(base16 + off);
        b0 = (f32x4){__builtin_bit_cast(float, w.x << 16), __builtin_bit_cast(float, w.x & 0xffff0000u), __builtin_bit_cast(float, w.y << 16), __builtin_bit_cast(float, w.y & 0xffff0000u)};
        b1 = (f32x4){__builtin_bit_cast(float, w.z << 16), __builtin_bit_cast(float, w.z & 0xffff0000u), __builtin_bit_cast(float, w.w << 16), __builtin_bit_cast(float, w.w & 0xffff0000u)}; }
}
struct EpiResidI8 {
    static constexpr bool PERM = true, AFTER_DRAIN = false, I8 = true, PREF = false; static constexpr int NSTORE = 0; typedef i32x4 acc_t;
    const float* base32; const bf16_t* base; bf16_t* out; const float* rs; const unsigned* cmax;
    __device__ __forceinline__ void operator()(const i32x4 (&acc)[2][2][4][2], const Unit& u, int wr, int wc, int fr, int fq) const {
        const int row0 = u.pm * BM + wr * 64 + fr, col0 = u.pn * BM + wc * 32 + 8 * fq;
        const unsigned* cm = cmax + col0;
        f32x4 sc[2][2];
#pragma unroll
        for (int bj = 0; bj < 2; ++bj)
#pragma unroll
            for (int n = 0; n < 2; ++n) sc[bj][n] = __builtin_bit_cast(f32x4, *(const u32x4*)(cm + bj * HALF + 4 * n)) * (1.f / 127.f);
#pragma unroll
        for (int ai = 0; ai < 2; ++ai)
#pragma unroll
            for (int m = 0; m < 4; ++m) { const int r = row0 + ai * HALF + m * 16; const float sa = rs[r];
#pragma unroll
                for (int bj = 0; bj < 2; ++bj) { const size_t off = (size_t)r * 2048 + col0 + bj * HALF; f32x4 b0, b1; ld_base8i(base32, base, off, b0, b1);
                    const f32x4 v0 = b0 + __builtin_convertvector(acc[ai][bj][m][0], f32x4) * (sc[bj][0] * sa), v1 = b1 + __builtin_convertvector(acc[ai][bj][m][1], f32x4) * (sc[bj][1] * sa);
                    u32x4 w; w.x = cvt_pk_bf16(v0[0], v0[1]); w.y = cvt_pk_bf16(v0[2], v0[3]); w.z = cvt_pk_bf16(v1[0], v1[1]); w.w = cvt_pk_bf16(v1[2], v1[3]);
                    *(u32x4*)(out + off) = w; } }
    }
};
constexpr float EPSN = 1e-6f;
template <int MODE> __device__ __forceinline__ float rowscale(const float* p, int r, int fq) {
    if constexpr (MODE == 0) { return 1.f; }
    else if constexpr (MODE == 1) { const f32x4 a = *(const f32x4*)(p + (size_t)r * 32 + 8 * fq), b = *(const f32x4*)(p + (size_t)r * 32 + 8 * fq + 4);
        float s = ((a[0] + a[1]) + (a[2] + a[3])) + ((b[0] + b[1]) + (b[2] + b[3])); s += __shfl_xor(s, 16); s += __shfl_xor(s, 32); return rsqrtf(s * (1.f / 2048.f) + EPSN); }
    else if constexpr (MODE == 2) { const f32x4 a = *(const f32x4*)(p + (size_t)r * 16 + 4 * fq);
        float s = (a[0] + a[1]) + (a[2] + a[3]); s += __shfl_xor(s, 16); s += __shfl_xor(s, 32); return rsqrtf(s * (1.f / 1024.f) + EPSN); }
    else { return p[r]; }
}
__device__ __forceinline__ void ld_base8(const float* base32, const bf16_t* base16, size_t off, f32x4& b0, f32x4& b1) {
    if (base32) { b0 = *(const f32x4*)(base32 + off); b1 = *(const f32x4*)(base32 + off + 4); }
    else { const u32x4 w = *(const u32x4*)(base16 + off);
        b0 = (f32x4){__builtin_bit_cast(float, w.x << 16), __builtin_bit_cast(float, w.x & 0xffff0000u), __builtin_bit_cast(float, w.y << 16), __builtin_bit_cast(float, w.y & 0xffff0000u)};
        b1 = (f32x4){__builtin_bit_cast(float, w.z << 16), __builtin_bit_cast(float, w.z & 0xffff0000u), __builtin_bit_cast(float, w.w << 16), __builtin_bit_cast(float, w.w & 0xffff0000u)}; }
}
template <int MODE> struct EpiResidB {
    static constexpr bool PERM = true, AFTER_DRAIN = false, I8 = false, PREF = false; typedef f32x4 acc_t;
    const float* base32; const bf16_t* base16; bf16_t* out; const float* sp;
    __device__ __forceinline__ void operator()(const f32x4 (&acc)[2][2][4][2], const Unit& u, int wr, int wc, int fr, int fq) const {
        const int row0 = u.pm * BM + wr * 64 + fr, col0 = u.pn * BM + wc * 32 + 8 * fq;
#pragma unroll
        for (int ai = 0; ai < 2; ++ai)
#pragma unroll
            for (int m = 0; m < 4; ++m) { const int r = row0 + ai * HALF + m * 16; const float sc = rowscale<MODE>(sp, r, fq);
#pragma unroll
                for (int bj = 0; bj < 2; ++bj) { const size_t off = (size_t)r * 2048 + col0 + bj * HALF; f32x4 b0, b1; ld_base8(base32, base16, off, b0, b1);
                    const f32x4 v0 = b0 + acc[ai][bj][m][0] * sc, v1 = b1 + acc[ai][bj][m][1] * sc;
                    u32x4 w; w.x = cvt_pk_bf16(v0[0], v0[1]); w.y = cvt_pk_bf16(v0[2], v0[3]); w.z = cvt_pk_bf16(v1[0], v1[1]); w.w = cvt_pk_bf16(v1[2], v1[3]);
                    *(u32x4*)(out + off) = w; } }
    }
};
struct EpiSwigluI8 {
    static constexpr bool PERM = true, AFTER_DRAIN = false, I8 = true, PREF = false; typedef i32x4 acc_t;
    bf16_t* O; int ldc; const float* as; const unsigned* cmax; int ncol;
    __device__ __forceinline__ void operator()(const i32x4 (&acc)[2][2][4][2], const Unit& u, int wr, int wc, int fr, int fq) const {
        const int row0 = u.pm * BM + wr * 64 + fr, col0 = u.pn * HALF + wc * 32 + 8 * fq;
        const unsigned* cm = cmax + (size_t)u.eid * ncol + u.pn * BM + wc * 32 + 8 * fq;
        f32x4 sg[2], su[2];
#pragma unroll
        for (int n = 0; n < 2; ++n) { const u32x4 a = *(const u32x4*)(cm + 4 * n), b = *(const u32x4*)(cm + HALF + 4 * n);
            sg[n] = __builtin_bit_cast(f32x4, a) * (1.f / 127.f); su[n] = __builtin_bit_cast(f32x4, b) * (1.f / 127.f); }
#pragma unroll
        for (int ai = 0; ai < 2; ++ai)
#pragma unroll
            for (int m = 0; m < 4; ++m) { const int r = row0 + ai * HALF + m * 16; const float sa = as[r];
                const f32x4 g0 = __builtin_convertvector(acc[ai][0][m][0], f32x4) * (sg[0] * sa), g1 = __builtin_convertvector(acc[ai][0][m][1], f32x4) * (sg[1] * sa);
                const f32x4 u0 = __builtin_convertvector(acc[ai][1][m][0], f32x4) * (su[0] * sa), u1 = __builtin_convertvector(acc[ai][1][m][1], f32x4) * (su[1] * sa);
                u32x4 w; w.x = cvt_pk_bf16(silu_mul(g0[0], u0[0]), silu_mul(g0[1], u0[1])); w.y = cvt_pk_bf16(silu_mul(g0[2], u0[2]), silu_mul(g0[3], u0[3]));
                w.z = cvt_pk_bf16(silu_mul(g1[0], u1[0]), silu_mul(g1[1], u1[1])); w.w = cvt_pk_bf16(silu_mul(g1[2], u1[2]), silu_mul(g1[3], u1[3]));
                *(u32x4*)(O + (size_t)r * ldc + col0) = w; }
    }
};

constexpr int PREF_OFF = 131072;
__device__ __forceinline__ void pref_issue(const float* rs_rows, const unsigned* cm_cols, PG8_LAS unsigned char* lds, int buf, int wid, int lane) {
    asm volatile("" : "+v"(lane));
    const unsigned* src = (wid < 4) ? (const unsigned*)rs_rows : cm_cols;
    __builtin_amdgcn_global_load_lds(src + ((wid & 3) * 64 + lane), (PG8_LAS unsigned*)(lds + PREF_OFF + buf * 2048 + wid * 256), 4, 0, 0);
}
struct EpiScaleBf16I8P {
    static constexpr bool PERM = true, AFTER_DRAIN = false, I8 = true, PREF = true; typedef i32x4 acc_t;
    bf16_t* O; int ldc; const float* rs; const unsigned* cmax; int ncol;
    __device__ __forceinline__ void prefetch(const Unit& u, PG8_LAS unsigned char* lds, int buf, int wid, int lane) const { pref_issue(rs + (size_t)u.pm * BM, cmax + (size_t)u.eid * ncol + u.pn * BM, lds, buf, wid, lane); }
    __device__ __forceinline__ void operator()(const i32x4 (&acc)[2][2][4][2], const Unit& u, int wr, int wc, int fr, int fq, PG8_LAS unsigned char* lds, int buf) const {
        const int row0 = u.pm * BM + wr * 64 + fr, col0 = u.pn * BM + wc * 32 + 8 * fq;
        const PG8_LAS float* rsl = (const PG8_LAS float*)(lds + PREF_OFF + buf * 2048) + wr * 64 + fr; const PG8_LAS unsigned* cml = (const PG8_LAS unsigned*)(lds + PREF_OFF + buf * 2048 + 1024) + wc * 32 + 8 * fq;
        f32x4 sc[2][2];
#pragma unroll
        for (int bj = 0; bj < 2; ++bj)
#pragma unroll
            for (int n = 0; n < 2; ++n) sc[bj][n] = __builtin_bit_cast(f32x4, *(const PG8_LAS u32x4*)(cml + bj * HALF + 4 * n)) * (1.f / 127.f);
#pragma unroll
        for (int ai = 0; ai < 2; ++ai)
#pragma unroll
            for (int m = 0; m < 4; ++m) { const int r = row0 + ai * HALF + m * 16; const float sa = rsl[ai * HALF + m * 16]; bf16_t* rowp = O + (size_t)r * ldc + col0;
#pragma unroll
                for (int bj = 0; bj < 2; ++bj) { const f32x4 v0 = __builtin_convertvector(acc[ai][bj][m][0], f32x4) * (sc[bj][0] * sa), v1 = __builtin_convertvector(acc[ai][bj][m][1], f32x4) * (sc[bj][1] * sa);
                    u32x4 w; w.x = cvt_pk_bf16(v0[0], v0[1]); w.y = cvt_pk_bf16(v0[2], v0[3]); w.z = cvt_pk_bf16(v1[0], v1[1]); w.w = cvt_pk_bf16(v1[2], v1[3]);
                    *(u32x4*)(rowp + bj * HALF) = w; } }
    }
};
struct EpiResidI8P {
    static constexpr bool PERM = true, AFTER_DRAIN = false, I8 = true, PREF = true; typedef i32x4 acc_t;
    const bf16_t* base; bf16_t* out; const float* rs; const unsigned* cmax;
    __device__ __forceinline__ void prefetch(const Unit& u, PG8_LAS unsigned char* lds, int buf, int wid, int lane) const { pref_issue(rs + (size_t)u.pm * BM, cmax + u.pn * BM, lds, buf, wid, lane); }
    __device__ __forceinline__ void operator()(const i32x4 (&acc)[2][2][4][2], const Unit& u, int wr, int wc, int fr, int fq, PG8_LAS unsigned char* lds, int buf) const {
        const PG8_LAS float* rsl = (const PG8_LAS float*)(lds + PREF_OFF + buf * 2048) + wr * 64 + fr; const PG8_LAS unsigned* cml = (const PG8_LAS unsigned*)(lds + PREF_OFF + buf * 2048 + 1024) + wc * 32 + 8 * fq;
        const size_t off0 = (size_t)(u.pm * BM + wr * 64 + fr) * 2048 + u.pn * BM + wc * 32 + 8 * fq;
        u32x4 rb[2][4][2];
#pragma unroll
        for (int ai = 0; ai < 2; ++ai)
#pragma unroll
            for (int m = 0; m < 4; ++m)
#pragma unroll
                for (int bj = 0; bj < 2; ++bj) rb[ai][m][bj] = *(const u32x4*)(base + off0 + (size_t)(ai * HALF + m * 16) * 2048 + bj * HALF);
        __builtin_amdgcn_sched_barrier(0);
        f32x4 sc[2][2];
#pragma unroll
        for (int bj = 0; bj < 2; ++bj)
#pragma unroll
            for (int n = 0; n < 2; ++n) sc[bj][n] = __builtin_bit_cast(f32x4, *(const PG8_LAS u32x4*)(cml + bj * HALF + 4 * n)) * (1.f / 127.f);
#pragma unroll
        for (int ai = 0; ai < 2; ++ai)
#pragma unroll
            for (int m = 0; m < 4; ++m) { const float sa = rsl[ai * HALF + m * 16];
#pragma unroll
                for (int bj = 0; bj < 2; ++bj) { const u32x4 w0 = rb[ai][m][bj];
                    const f32x4 b0 = {__builtin_bit_cast(float, w0.x << 16), __builtin_bit_cast(float, w0.x & 0xffff0000u), __builtin_bit_cast(float, w0.y << 16), __builtin_bit_cast(float, w0.y & 0xffff0000u)};
                    const f32x4 b1 = {__builtin_bit_cast(float, w0.z << 16), __builtin_bit_cast(float, w0.z & 0xffff0000u), __builtin_bit_cast(float, w0.w << 16), __builtin_bit_cast(float, w0.w & 0xffff0000u)};
                    const f32x4 v0 = b0 + __builtin_convertvector(acc[ai][bj][m][0], f32x4) * (sc[bj][0] * sa), v1 = b1 + __builtin_convertvector(acc[ai][bj][m][1], f32x4) * (sc[bj][1] * sa);
                    u32x4 w; w.x = cvt_pk_bf16(v0[0], v0[1]); w.y = cvt_pk_bf16(v0[2], v0[3]); w.z = cvt_pk_bf16(v1[0], v1[1]); w.w = cvt_pk_bf16(v1[2], v1[3]);
                    *(u32x4*)(out + off0 + (size_t)(ai * HALF + m * 16) * 2048 + bj * HALF) = w; } }
    }
};
struct EpiSwigluI8P {
    static constexpr bool PERM = true, AFTER_DRAIN = false, I8 = true, PREF = true; typedef i32x4 acc_t;
    bf16_t* O; int ldc; const float* as; const unsigned* cmax; int ncol;
    __device__ __forceinline__ void prefetch(const Unit& u, PG8_LAS unsigned char* lds, int buf, int wid, int lane) const { pref_issue(as + (size_t)u.pm * BM, cmax + (size_t)u.eid * ncol + u.pn * BM, lds, buf, wid, lane); }
    __device__ __forceinline__ void operator()(const i32x4 (&acc)[2][2][4][2], const Unit& u, int wr, int wc, int fr, int fq, PG8_LAS unsigned char* lds, int buf) const {
        const int row0 = u.pm * BM + wr * 64 + fr, col0 = u.pn * HALF + wc * 32 + 8 * fq;
        const PG8_LAS float* rsl = (const PG8_LAS float*)(lds + PREF_OFF + buf * 2048) + wr * 64 + fr; const PG8_LAS unsigned* cml = (const PG8_LAS unsigned*)(lds + PREF_OFF + buf * 2048 + 1024) + wc * 32 + 8 * fq;
        f32x4 sg[2], su[2];
#pragma unroll
        for (int n = 0; n < 2; ++n) { sg[n] = __builtin_bit_cast(f32x4, *(const PG8_LAS u32x4*)(cml + 4 * n)) * (1.f / 127.f); su[n] = __builtin_bit_cast(f32x4, *(const PG8_LAS u32x4*)(cml + HALF + 4 * n)) * (1.f / 127.f); }
#pragma unroll
        for (int ai = 0; ai < 2; ++ai)
#pragma unroll
            for (int m = 0; m < 4; ++m) { const int r = row0 + ai * HALF + m * 16; const float sa = rsl[ai * HALF + m * 16];
                const f32x4 g0 = __builtin_convertvector(acc[ai][0][m][0], f32x4) * (sg[0] * sa), g1 = __builtin_convertvector(acc[ai][0][m][1], f32x4) * (sg[1] * sa);
                const f32x4 u0 = __builtin_convertvector(acc[ai][1][m][0], f32x4) * (su[0] * sa), u1 = __builtin_convertvector(acc[ai][1][m][1], f32x4) * (su[1] * sa);
                u32x4 w; w.x = cvt_pk_bf16(silu_mul(g0[0], u0[0]), silu_mul(g0[1], u0[1])); w.y = cvt_pk_bf16(silu_mul(g0[2], u0[2]), silu_mul(g0[3], u0[3]));
                w.z = cvt_pk_bf16(silu_mul(g1[0], u1[0]), silu_mul(g1[1], u1[1])); w.w = cvt_pk_bf16(silu_mul(g1[2], u1[2]), silu_mul(g1[3], u1[3]));
                *(u32x4*)(O + (size_t)r * ldc + col0) = w; }
    }
};
template <bool I8, class AccT> __device__ __forceinline__ AccT mma16(bf16x8 a, bf16x8 b, AccT c) {
    if constexpr (I8) return __builtin_amdgcn_mfma_i32_16x16x64_i8(__builtin_bit_cast(i32x4, a), __builtin_bit_cast(i32x4, b), c, 0, 0, 0);
    else return __builtin_amdgcn_mfma_f32_16x16x32_bf16(a, b, c, 0, 0, 0);
}
template <class Epi, class Sched, bool ALIGN_EPI = false, bool SP2 = false>
__device__ __forceinline__ void gemm_phase(PG8_LAS unsigned char* lds, const Gemm g, const Sched& S, const Epi& E) {
    int tid_ = threadIdx.x; asm volatile("" : "+v"(tid_));
    const int tid = tid_, wid = __builtin_amdgcn_readfirstlane(tid >> 6), lane = tid & 63, wr = wid >> 2, wc = wid & 3, fr = lane & 15, fq = lane >> 4;
    const int K = g.K, nt = K / BK;
    unsigned voffA[2], voffB[2];
#pragma unroll
    for (int i = 0; i < 2; ++i) { int R, C; stage_rc(tid * 16 + i * 8192, R, C); const int Rb = Epi::PERM ? ((R & ~31) + perm32(R & 31)) : R;
        voffA[i] = (unsigned)(R * K + C) * 2u; voffB[i] = (unsigned)(Rb * K + C) * 2u; }
    const size_t kstep = (size_t)(BK * 2);
    const size_t hstep = (size_t)HALF * K * 2;
    const size_t tstep = 2 * hstep;
    const unsigned ldsw = (unsigned)wid * 1024u;
    const int aoff = lds_byte(wr * 64 + fr, fq * 8), boff = lds_byte(wc * 32 + fr, fq * 8);
#define PG8_SA(b, h) (((b) * 2 + (h)) * HTB)
#define PG8_SB(b, h) ((4 + (b) * 2 + (h)) * HTB)
#define PG8_STAGE(bufoff, gbase, voff) do { _Pragma("unroll") for (int _i = 0; _i < 2; ++_i) \
        __builtin_amdgcn_global_load_lds((const unsigned*)((const char*)(gbase) + (voff)[_i]), (PG8_LAS unsigned*)(lds + (bufoff) + ldsw + _i * 8192), 16, 0, 0); } while (0)
#define PG8_LDA(dst, b, h) do { _Pragma("unroll") for (int m = 0; m < 4; ++m) _Pragma("unroll") for (int k = 0; k < 2; ++k) dst[m][k] = *(const PG8_LAS bf16x8*)(lds + PG8_SA(b, h) + aoff + m * 2048 + k * 1024); } while (0)
#define PG8_LDB(dst, b, h) do { _Pragma("unroll") for (int n = 0; n < 2; ++n) _Pragma("unroll") for (int k = 0; k < 2; ++k) dst[n][k] = *(const PG8_LAS bf16x8*)(lds + PG8_SB(b, h) + boff + n * 2048 + k * 1024); } while (0)
#define PG8_MMA(ai, bj, At, Bt) do { __builtin_amdgcn_s_setprio(1); _Pragma("unroll") for (int m = 0; m < 4; ++m) _Pragma("unroll") for (int n = 0; n < 2; ++n) _Pragma("unroll") for (int k = 0; k < 2; ++k) \
        acc[ai][bj][m][n] = mma16<Epi::I8>(Bt[n][k], At[m][k], acc[ai][bj][m][n]); __builtin_amdgcn_s_setprio(0); } while (0)
#define PG8_WAIT_V(n) asm volatile("s_waitcnt vmcnt(" #n ")" ::: "memory")
#define PG8_WAIT_L(n) asm volatile("s_waitcnt lgkmcnt(" #n ")" ::: "memory")
#define PG8_BAR __builtin_amdgcn_s_barrier()
#define PG8_SCHED __builtin_amdgcn_sched_barrier(0)
    Unit cur, nxt; int ui = 0;
    if (!S.next(0, cur)) return;
    typedef typename Epi::acc_t acc_t; acc_t acc[2][2][4][2];
#pragma unroll
    for (int a = 0; a < 2; ++a)
#pragma unroll
        for (int b = 0; b < 2; ++b)
#pragma unroll
            for (int m = 0; m < 4; ++m)
#pragma unroll
                for (int n = 0; n < 2; ++n) acc[a][b][m][n] = acc_t{};
    bf16x8 At[4][2], B0[2][2], B1[2][2];
    const char* cA = (const char*)g.A + (size_t)cur.pm * tstep; const char* cB = (const char*)g.Bt + cur.bofs + (size_t)cur.pn * tstep;
    S.a_ready(cur);
    int ubuf = 0;
    if constexpr (Epi::PREF) E.prefetch(cur, lds, ubuf, wid, lane);
    if constexpr (SP2) {
        PG8_STAGE(PG8_SB(0, 0), cB, voffB); PG8_STAGE(PG8_SB(0, 1), cB + hstep, voffB); PG8_STAGE(PG8_SA(0, 0), cA, voffA); PG8_STAGE(PG8_SA(0, 1), cA + hstep, voffA);
        if (wr == 1) PG8_BAR;
        PG8_WAIT_V(2); PG8_BAR;
        PG8_STAGE(PG8_SB(1, 0), cB + kstep, voffB); PG8_STAGE(PG8_SA(1, 0), cA + kstep, voffA); PG8_STAGE(PG8_SB(1, 1), cB + hstep + kstep, voffB);
        PG8_WAIT_V(6); PG8_BAR;
    } else {
        PG8_STAGE(PG8_SB(0, 0), cB, voffB); PG8_STAGE(PG8_SA(0, 0), cA, voffA); PG8_STAGE(PG8_SB(0, 1), cB + hstep, voffB); PG8_STAGE(PG8_SA(0, 1), cA + hstep, voffA);
        if (wr == 1) PG8_BAR;
        PG8_WAIT_V(4); PG8_BAR;
        PG8_STAGE(PG8_SB(1, 0), cB + kstep, voffB); PG8_STAGE(PG8_SA(1, 0), cA + kstep, voffA); PG8_STAGE(PG8_SB(1, 1), cB + hstep + kstep, voffB);
        PG8_WAIT_V(6); PG8_BAR;
    }
    for (;;) {
        const bool has_next = S.next(ui + 1, nxt);
        const char* nA = has_next ? (const char*)g.A + (size_t)nxt.pm * tstep : cA; const char* nB = has_next ? (const char*)g.Bt + nxt.bofs + (size_t)nxt.pn * tstep : cB;
        for (int t = 0; t < nt; t += 2) {
            const bool last = (t == nt - 2);
            const char* a1 = cA + (size_t)(t + 1) * kstep;
            const char* a2 = last ? nA : cA + (size_t)(t + 2) * kstep; const char* b2 = last ? nB : cB + (size_t)(t + 2) * kstep;
            const char* a3 = a2 + kstep; const char* b3 = b2 + kstep;
            if (last && has_next) S.a_ready(nxt);
            if constexpr (SP2) {
            PG8_LDB(B0, 0, 0); PG8_LDB(B1, 0, 1); PG8_SCHED; PG8_LDA(At, 0, 0); PG8_STAGE(PG8_SA(1, 1), a1 + hstep, voffA);
            PG8_WAIT_V(8); PG8_WAIT_L(0); PG8_BAR; PG8_MMA(0, 0, At, B0); PG8_MMA(0, 1, At, B1); PG8_BAR; PG8_SCHED;
            PG8_LDA(At, 0, 1); PG8_STAGE(PG8_SB(0, 0), b2, voffB); PG8_STAGE(PG8_SB(0, 1), b2 + hstep, voffB); PG8_STAGE(PG8_SA(0, 0), a2, voffA);
            PG8_WAIT_V(8); PG8_WAIT_L(0); PG8_BAR; PG8_MMA(1, 0, At, B0); PG8_MMA(1, 1, At, B1); PG8_BAR; PG8_SCHED;
            PG8_LDB(B0, 1, 0); PG8_LDB(B1, 1, 1); PG8_SCHED; PG8_LDA(At, 1, 0); PG8_STAGE(PG8_SA(0, 1), a2 + hstep, voffA);
            PG8_WAIT_V(8); PG8_WAIT_L(0); PG8_BAR; PG8_MMA(0, 0, At, B0); PG8_MMA(0, 1, At, B1); PG8_BAR; PG8_SCHED;
            PG8_LDA(At, 1, 1); PG8_STAGE(PG8_SB(1, 0), b3, voffB); PG8_STAGE(PG8_SB(1, 1), b3 + hstep, voffB); PG8_STAGE(PG8_SA(1, 0), a3, voffA);
            PG8_WAIT_V(8); PG8_WAIT_L(0); PG8_BAR; PG8_MMA(1, 0, At, B0); PG8_MMA(1, 1, At, B1); PG8_BAR; PG8_SCHED;
            } else {
            PG8_LDB(B0, 0, 0); PG8_SCHED; PG8_LDA(At, 0, 0); PG8_STAGE(PG8_SA(1, 1), a1 + hstep, voffA);
            PG8_WAIT_L(8); PG8_BAR; PG8_WAIT_L(0); PG8_MMA(0, 0, At, B0); PG8_BAR; PG8_SCHED;
            PG8_LDB(B1, 0, 1); PG8_STAGE(PG8_SB(0, 0), b2, voffB);
            PG8_BAR; PG8_WAIT_L(0); PG8_MMA(0, 1, At, B1); PG8_BAR;
            PG8_LDA(At, 0, 1); PG8_STAGE(PG8_SA(0, 0), a2, voffA);
            PG8_BAR; PG8_WAIT_L(0); PG8_MMA(1, 0, At, B0); PG8_BAR; PG8_SCHED;
            PG8_STAGE(PG8_SB(0, 1), b2 + hstep, voffB);
            PG8_WAIT_V(6); PG8_BAR; PG8_MMA(1, 1, At, B1); PG8_BAR;
            PG8_LDB(B0, 1, 0); PG8_SCHED; PG8_LDA(At, 1, 0); PG8_STAGE(PG8_SA(0, 1), a2 + hstep, voffA);
            PG8_WAIT_L(8); PG8_BAR; PG8_WAIT_L(0); PG8_MMA(0, 0, At, B0); PG8_BAR; PG8_SCHED;
            PG8_LDB(B1, 1, 1); PG8_STAGE(PG8_SB(1, 0), b3, voffB);
            PG8_BAR; PG8_WAIT_L(0); PG8_MMA(0, 1, At, B1); PG8_BAR;
            PG8_LDA(At, 1, 1); PG8_STAGE(PG8_SA(1, 0), a3, voffA);
            PG8_BAR; PG8_WAIT_L(0); PG8_MMA(1, 0, At, B0); PG8_BAR; PG8_SCHED;
            PG8_STAGE(PG8_SB(1, 1), b3 + hstep, voffB);
            PG8_WAIT_V(6); PG8_BAR; PG8_MMA(1, 1, At, B1); PG8_BAR;
            }
        }
        if constexpr (ALIGN_EPI) { if (wr == 0) PG8_BAR; }
        if constexpr (!Epi::AFTER_DRAIN) { if constexpr (Epi::PREF) E(acc, cur, wr, wc, fr, fq, lds, ubuf); else E(acc, cur, wr, wc, fr, fq); S.done(cur); }
        if (!has_next) break;
#pragma unroll
        for (int a = 0; a < 2; ++a)
#pragma unroll
            for (int b = 0; b < 2; ++b)
#pragma unroll
                for (int m = 0; m < 4; ++m)
#pragma unroll
                    for (int n = 0; n < 2; ++n) acc[a][b][m][n] = acc_t{};
        cur = nxt; cA = nA; cB = nB; ++ui;
        if constexpr (Epi::PREF) { ubuf ^= 1; E.prefetch(cur, lds, ubuf, wid, lane); }
        if constexpr (ALIGN_EPI) { if (wr == 1) PG8_BAR; }
    }
    PG8_WAIT_V(0);
    if constexpr (!ALIGN_EPI) { if (wr == 0) PG8_BAR; }
    PG8_BAR;
    if constexpr (Epi::AFTER_DRAIN) { E.fused(acc, cur, wr, wc, fr, fq, lds, wid, lane); S.done(cur); }
#undef PG8_SA
#undef PG8_SB
#undef PG8_STAGE
#undef PG8_LDA
#undef PG8_LDB
#undef PG8_MMA
#undef PG8_WAIT_V
#undef PG8_WAIT_L
#undef PG8_BAR
#undef PG8_SCHED
}
}
#ifndef PG8_SP2
#define PG8_SP2 true
#endif
#ifndef PG8_ALIGN
#define PG8_ALIGN true
#endif
constexpr int NWAVES = 8;
constexpr int BATCH = 4, SEQ = 4096, T = BATCH * SEQ, D = 2048, DIN = 3840, DFF = 5632, DE = 2816, NE = 8;
constexpr int C_Q = 0, C_K = 1024, C_V = 1152, C_CB = 1280, C_CC = 1792, C_CX = 2304, C_LX = 2816, C_LG = 3328;
constexpr int MAXP = 136, MROWS = MAXP * 256;
constexpr float EPS = 1e-6f, LOG2E = 1.4426950408889634f;
constexpr int N_PHASES = 20;
constexpr size_t MiB = 1u << 20, KiB = 1u << 10;
constexpr size_t WS_CTL = 0, CTL_ZERO_BYTES = 64 * KiB;
constexpr size_t WS_CMAX = 256 * KiB;
constexpr int CM_GU = 0, CM_EGU = 2 * DFF, CM_IN = CM_EGU + 8 * 2 * DE, CM_OUT = CM_IN + 2 * DIN, CM_D = CM_OUT + 2 * D, CM_ED = CM_D + D, CM_END = CM_ED + 8 * D;
constexpr size_t WS_SSQA = 3 * MiB;
constexpr size_t WS_LSUM = 4 * MiB;
constexpr size_t WS_AS = 5 * MiB;
constexpr size_t WS_TOKE = WS_AS + 64 * KiB;
constexpr size_t WS_TOKW = WS_TOKE + 64 * KiB;
constexpr size_t WS_LRANK = WS_TOKW + 128 * KiB;
constexpr size_t WS_POS = WS_LRANK + 64 * KiB;
constexpr size_t WS_BLKCNT = WS_POS + 128 * KiB;
constexpr size_t WS_SEG = WS_BLKCNT + 8 * KiB;
constexpr size_t WS_ASS = 6 * MiB;
constexpr size_t WS_GWS = WS_ASS + 256 * KiB;
constexpr size_t WS_ASM = WS_GWS + 256 * KiB;
constexpr size_t WS_ASD = WS_ASM + 64 * KiB;
constexpr size_t WS_ASDM = WS_ASD + 64 * KiB;
constexpr size_t WS_RWT = 8 * MiB;
constexpr size_t WS_WAT = 7 * MiB;
constexpr size_t WS_WXT = WS_WAT + 128 * KiB;
constexpr size_t WS_WIN = 17 * MiB;
constexpr size_t WS_WOUT = 32 * MiB;
constexpr size_t WS_WGU = 48 * MiB;
constexpr size_t WS_WD = 70 * MiB;
constexpr size_t WS_EGU = 81 * MiB;
constexpr size_t WS_ED = 169 * MiB;
constexpr size_t WS_XB = 213 * MiB;
constexpr size_t WS_XA = 277 * MiB;
constexpr size_t WS_XQ8 = 341 * MiB;
constexpr size_t WS_PROJ = 373 * MiB;
constexpr size_t WS_AMIXB = 493 * MiB;
constexpr size_t WS_AMIX8 = 525 * MiB;
constexpr size_t WS_WOF = 557 * MiB;
constexpr size_t WS_ACT = 373 * MiB;
constexpr size_t WS_ACT8 = 557 * MiB;
constexpr size_t WS_XP = 373 * MiB;
constexpr size_t WS_ACTM = 441 * MiB;
constexpr size_t WS_ACTM8 = 628 * MiB;
constexpr size_t WS_Y = 373 * MiB;
constexpr size_t WS_END = 722 * MiB;
static_assert(WS_CMAX + (size_t)CM_END * 4 <= 1 * MiB && (8192 * 4 + 8 * 256) <= CTL_ZERO_BYTES, "cmax / ctl (barrier words end at u32 index 4096 + 3456, hand-off words at 8192 + 8 * 64)");
static_assert(WS_WIN + 2ull * DIN * D <= WS_WOUT && WS_WOUT + 2ull * D * D * 2 <= WS_WGU && WS_WGU + 2ull * DFF * D <= WS_WD && WS_WD + (size_t)D * DFF <= WS_EGU && WS_EGU + 8ull * 2 * DE * D <= WS_ED && WS_ED + 8ull * D * DE <= WS_XB, "ws map 1");
static_assert(WS_XB + (size_t)T * D * 2 <= WS_XA && WS_XA + (size_t)T * D * 2 <= WS_XQ8 && WS_XQ8 + (size_t)T * D <= WS_PROJ && WS_PROJ + (size_t)T * DIN * 2 <= WS_AMIXB && WS_AMIXB + (size_t)T * 1024 * 2 <= WS_AMIX8 && WS_AMIX8 + (size_t)T * D <= WS_ACT8 && WS_WOF + 2ull * D * D * 4 <= WS_END, "ws map 2");
static_assert(WS_ACT + (size_t)T * DFF * 2 <= WS_ACT8 && WS_ACT8 + (size_t)T * DFF <= WS_END && WS_XP + (size_t)MROWS * D <= WS_ACTM && WS_ACTM + (size_t)MROWS * DE * 2 <= WS_ACTM8 && WS_ACTM8 + (size_t)MROWS * DE <= WS_END && WS_Y + (size_t)MROWS * D * 2 <= WS_ACTM8, "ws map 3");
constexpr int CW_BAR = 4096;
constexpr int CW_FLOW = 8192;
constexpr int RING_BYTES = 131072, LDSCTL_OFF = 143360, MISC_OFF = LDSCTL_OFF + 320, LDS_BYTES = 147456;
constexpr int LRU_WREG = 17408;
static_assert(8 * LRU_WREG <= LDSCTL_OFF, "LRU scratch");

#define GAS __attribute__((address_space(1)))
#define LAS __attribute__((address_space(3)))
typedef unsigned short bf16;
typedef unsigned v4u __attribute__((ext_vector_type(4)));
typedef unsigned v2u __attribute__((ext_vector_type(2)));
typedef float f32x4 __attribute__((ext_vector_type(4)));
typedef float f32x16 __attribute__((ext_vector_type(16)));
typedef short bf16x8 __attribute__((ext_vector_type(8)));
typedef GAS unsigned gu32;
#define RLX_AGENT __ATOMIC_RELAXED, __HIP_MEMORY_SCOPE_AGENT
#define LDS_WAIT() asm volatile("s_waitcnt lgkmcnt(0)" ::: "memory")
#define MFMA32(a, b, c) __builtin_amdgcn_mfma_f32_32x32x16_bf16((a), (b), (c), 0, 0, 0)
__device__ __forceinline__ unsigned f2bf(float f) { unsigned u = __builtin_bit_cast(unsigned, f); return (u + 0x7fffu + ((u >> 16) & 1u)) >> 16; }
__device__ __forceinline__ unsigned pk2(float lo, float hi) { return pg8::cvt_pk_bf16(lo, hi); }
__device__ __forceinline__ float bflo(unsigned w) { return __builtin_bit_cast(float, w << 16); }
__device__ __forceinline__ float bfhi(unsigned w) { return __builtin_bit_cast(float, w & 0xffff0000u); }
__device__ __forceinline__ float bf1(bf16 h) { return __builtin_bit_cast(float, (unsigned)h << 16); }
__device__ __forceinline__ float wave_sum(float v) {
#pragma unroll
    for (int o = 1; o < 64; o <<= 1) v += __shfl_xor(v, o);
    return v;
}
__device__ __forceinline__ int wave_sum_i(int v) {
#pragma unroll
    for (int o = 1; o < 64; o <<= 1) v += __shfl_xor(v, o);
    return v;
}
__device__ __forceinline__ float sigmoidf_(float x) { return __builtin_amdgcn_rcpf(1.f + __builtin_amdgcn_exp2f(-LOG2E * x)); }

#define XB_TMO      128
#define XB_XCNT(j)  (256  + 64 * (j))
#define XB_XSUB(j)  (1280 + 64 * (j))
#define XB_XGEN(j)  (2304 + 64 * (j))
#define XB_TOP      3328
#define XB_TOPGEN   3392
#define XCD_BAR_WORDS 3456
#define XB_SPIN_CAP (1u << 22)
__device__ __forceinline__ unsigned xb_ld(unsigned* p)              { return __hip_atomic_load(p, __ATOMIC_RELAXED, __HIP_MEMORY_SCOPE_AGENT); }
__device__ __forceinline__ unsigned xb_add(unsigned* p, unsigned v) { return __hip_atomic_fetch_add(p, v, __ATOMIC_RELAXED, __HIP_MEMORY_SCOPE_AGENT); }
__device__ __forceinline__ unsigned xb_xcc_id() { return (unsigned)__builtin_amdgcn_s_getreg((3 << 11) | 20) & 0xFu; }
#define XB_SPIN(cond, bar) do { unsigned _sp = 0; while (cond) { __builtin_amdgcn_s_sleep(1); \
    if ((++_sp & 255u) == 0u) { if (xb_ld(&(bar)[XB_TMO])) break; if (_sp > XB_SPIN_CAP) { atomicAdd(&(bar)[XB_TMO], 1u); break; } } } } while (0)
struct XcdBarrier { unsigned* bar; unsigned x; volatile LAS unsigned* st; };
__device__ __forceinline__ XcdBarrier xcd_barrier_post(unsigned* bar, volatile LAS unsigned* st) {
    XcdBarrier b; b.bar = bar; b.x = xb_xcc_id(); b.st = st;
    if (threadIdx.x == 0) (void)xb_add(&bar[XB_XCNT(b.x)], 1u);
    return b;
}
__device__ __forceinline__ void xcd_barrier_complete(unsigned* bar, unsigned x, unsigned& nloc, unsigned& nx) {
    const unsigned G = gridDim.x * gridDim.y * gridDim.z;
    unsigned sum, cnt, mine, sp = 0u;
    for (;;) {
        sum = 0u; cnt = 0u; mine = 0u;
#pragma unroll
        for (unsigned j = 0; j < 16; ++j) { const unsigned c = xb_ld(&bar[XB_XCNT(j)]); sum += c; cnt += (c > 0u) ? 1u : 0u; mine = (j == x) ? c : mine; }
        if (sum == G) break;
        __builtin_amdgcn_s_sleep(1);
        if ((++sp & 255u) == 0u) { if (xb_ld(&bar[XB_TMO])) break; if (sp > XB_SPIN_CAP) { atomicAdd(&bar[XB_TMO], 1u); break; } }
    }
    nloc = mine > 0u ? mine : 1u; nx = cnt > 0u ? cnt : 1u;
}
__device__ __forceinline__ void xcd_census(const XcdBarrier& b) {
    if (threadIdx.x < 64u) {
        unsigned* bar = b.bar; const unsigned lane = threadIdx.x, G = gridDim.x * gridDim.y * gridDim.z, x = (unsigned)__builtin_amdgcn_readfirstlane((int)b.x);
        unsigned sum, cnt, mine, sp = 0u;
        for (;;) {
            const unsigned c = (lane < 16u) ? xb_ld(&bar[XB_XCNT(lane)]) : 0u;
            sum = c;
#pragma unroll
            for (int o = 1; o < 64; o <<= 1) sum += (unsigned)__shfl_xor((int)sum, o);
            cnt = (unsigned)__popcll(__ballot(c > 0u)); mine = (unsigned)__builtin_amdgcn_readlane((int)c, (int)x);
            if (sum == G) break;
            __builtin_amdgcn_s_sleep(1);
            if ((++sp & 255u) == 0u) { if (xb_ld(&bar[XB_TMO])) break; if (sp > XB_SPIN_CAP) { if (lane == 0u) atomicAdd(&bar[XB_TMO], 1u); break; } }
        }
        if (lane == 0u) { b.st[0] = mine > 0u ? mine : 1u; b.st[1] = cnt > 0u ? cnt : 1u; }
        __builtin_amdgcn_s_waitcnt(0);
    }
}
__device__ __forceinline__ void xcd_barrier(const XcdBarrier& b) {
    asm volatile("s_waitcnt vmcnt(0)" ::: "memory");
    __syncthreads();
    if (threadIdx.x == 0) {
        unsigned* bar = b.bar;
        __builtin_amdgcn_s_waitcnt(0);
        unsigned nloc = b.st[0], nx = b.st[1];
        if (nloc == 0u) { xcd_barrier_complete(bar, b.x, nloc, nx); b.st[0] = nloc; b.st[1] = nx; }
        const unsigned old = xb_add(&bar[XB_XSUB(b.x)], 1u);
        const unsigned gen = old / nloc;
        if (old + 1u == (gen + 1u) * nloc) {
            __builtin_amdgcn_fence(__ATOMIC_RELEASE, "agent");
            asm volatile("s_waitcnt vmcnt(0)" ::: "memory");
            const unsigned og = xb_add(&bar[XB_TOP], 1u);
            const unsigned tg = og / nx;
            if (og + 1u == (tg + 1u) * nx) xb_add(&bar[XB_TOPGEN], 1u);
            else XB_SPIN(xb_ld(&bar[XB_TOPGEN]) == tg, bar);
        } else {
            XB_SPIN(xb_ld(&bar[XB_TOPGEN]) == gen, bar);
        }
        __builtin_amdgcn_fence(__ATOMIC_ACQUIRE, "agent");
        asm volatile("s_waitcnt vmcnt(0)" ::: "memory");
    }
    __syncthreads();
}

struct Args { const float* in[23]; float* out; unsigned char* ws; int ph_lo, ph_hi; };
struct Frame {
    LAS unsigned char* lds;
    int tid, lane, wave, G;
};
template <int K, int NW, bool GAIN> __device__ __forceinline__ void quant_slab(const float* W, int N, const float* gain, signed char* WT, unsigned* cm, const Frame& F) {
    constexpr int RPW = 64 / NW, RSTEP = 8 * RPW, NV = K / RSTEP, RS = K + 4;
    constexpr bool PACK = NV > 128;
    static_assert(K % (4 * RSTEP) == 0 && NV % 4 == 0 && (NW * K / 16) % 512 == 0 && NW * RS + 1024 <= LDSCTL_OFF, "slab geometry");
    const int lane = F.lane, n = lane % NW, rq = lane / NW, w = F.wave;
    LAS unsigned char* T8 = (LAS unsigned char*)F.lds; LAS float* red = (LAS float*)(F.lds + NW * RS);
    const __amdgpu_buffer_rsrc_t rs = __builtin_amdgcn_make_buffer_rsrc((void*)W, 0, 0x7ffffff0, 0x00020000);
    const int kb = 4 * (RPW * w + rq);
    const unsigned vo = (unsigned)((kb * N + n) * 4);
#define SLAB_K(s) (4 * RSTEP * ((s) >> 2) + ((s) & 3))
#define SLAB_SO(s) ((unsigned)(SLAB_K(s) * N * 4))
    float m = 0.f;
    if constexpr (!PACK) {
        float v[NV];
#pragma unroll
        for (int s = 0; s < NV; ++s) v[s] = __builtin_bit_cast(float, __builtin_amdgcn_raw_buffer_load_b32(rs, vo, SLAB_SO(s), 0));
        if constexpr (GAIN) {
#pragma unroll
            for (int s = 0; s < NV; ++s) v[s] *= gain[SLAB_K(s) + kb]; }
#pragma unroll
        for (int s = 0; s < NV; ++s) m = fmaxf(m, fabsf(v[s]));
#pragma unroll
        for (int o = NW; o < 64; o <<= 1) m = fmaxf(m, __shfl_xor(m, o));
        if (rq == 0) red[w * NW + n] = m;
        __syncthreads();
#pragma unroll
        for (int i = 0; i < 8; ++i) m = fmaxf(m, red[i * NW + n]);
        if (w == 0 && rq == 0) cm[n] = __float_as_uint(m);
        const float inv = 127.f / fmaxf(m, 1e-30f);
#pragma unroll
        for (int s = 0; s < NV; s += 4) { const int a0 = (int)__builtin_rintf(v[s] * inv), a1 = (int)__builtin_rintf(v[s + 1] * inv), a2 = (int)__builtin_rintf(v[s + 2] * inv), a3 = (int)__builtin_rintf(v[s + 3] * inv);
            *(LAS unsigned*)(T8 + n * RS + SLAB_K(s) + kb) = ((unsigned)a0 & 255u) | (((unsigned)a1 & 255u) << 8) | (((unsigned)a2 & 255u) << 16) | ((unsigned)a3 << 24);
            if ((s & 28) == 28) __builtin_amdgcn_sched_barrier(0); }
    } else {
        unsigned pk[NV / 2];
        constexpr int BATCH = 16;
        static_assert(NV % BATCH == 0, "slab batch");
#pragma unroll
        for (int s0 = 0; s0 < NV; s0 += BATCH) { float x[BATCH];
#pragma unroll
            for (int i = 0; i < BATCH; ++i) x[i] = __builtin_bit_cast(float, __builtin_amdgcn_raw_buffer_load_b32(rs, vo, SLAB_SO(s0 + i), 0));
            if constexpr (GAIN) {
#pragma unroll
                for (int i = 0; i < BATCH; ++i) x[i] *= gain[SLAB_K(s0 + i) + kb]; }
#pragma unroll
            for (int i = 0; i < BATCH; i += 2) { m = fmaxf(m, fmaxf(fabsf(x[i]), fabsf(x[i + 1]))); unsigned p_ = pk2(x[i], x[i + 1]); asm volatile("" : "+v"(p_)); pk[(s0 + i) / 2] = p_; }
            asm volatile("" ::: "memory"); __builtin_amdgcn_sched_barrier(0); }
#pragma unroll
        for (int o = NW; o < 64; o <<= 1) m = fmaxf(m, __shfl_xor(m, o));
        if (rq == 0) red[w * NW + n] = m;
        __syncthreads();
#pragma unroll
        for (int i = 0; i < 8; ++i) m = fmaxf(m, red[i * NW + n]);
        if (w == 0 && rq == 0) cm[n] = __float_as_uint(m);
        const float inv = 127.f / fmaxf(m, 1e-30f);
#pragma unroll
        for (int s = 0; s < NV; s += 4) { const int a0 = (int)__builtin_rintf(bflo(pk[s / 2]) * inv), a1 = (int)__builtin_rintf(bfhi(pk[s / 2]) * inv), a2 = (int)__builtin_rintf(bflo(pk[s / 2 + 1]) * inv), a3 = (int)__builtin_rintf(bfhi(pk[s / 2 + 1]) * inv);
            *(LAS unsigned*)(T8 + n * RS + SLAB_K(s) + kb) = ((unsigned)a0 & 255u) | (((unsigned)a1 & 255u) << 8) | (((unsigned)a2 & 255u) << 16) | ((unsigned)a3 << 24);
            if ((s & 28) == 28) __builtin_amdgcn_sched_barrier(0); }
    }
#undef SLAB_K
#undef SLAB_SO
    __syncthreads();
#pragma unroll
    for (int j = 0; j < NW * K / 16 / 512; ++j) { const int ci = F.tid + 512 * j, nn = ci / (K / 16), c = ci % (K / 16);
        const LAS unsigned* src = (const LAS unsigned*)(T8 + nn * RS + 16 * c); v4u o; o.x = src[0]; o.y = src[1]; o.z = src[2]; o.w = src[3];
        *(GAS v4u*)(WT + (size_t)nn * K + 16 * c) = o;
        if ((j & 3) == 3) __builtin_amdgcn_sched_barrier(0); }
    __syncthreads();
}
__device__ __forceinline__ void wht_panel(const float* W, const float* gain, float* O, const Frame& F) {
    LAS float* L = (LAS float*)F.lds;
    const int t = F.tid, c4 = t & 7, r0 = t >> 3;
#pragma unroll
    for (int j = 0; j < 8; ++j) { const int k = r0 + 64 * j; const f32x4 v = *(const GAS f32x4*)(W + (size_t)k * D + 4 * c4) * gain[k]; LAS float* p = L + k * 33 + 4 * c4; p[0] = v.x; p[1] = v.y; p[2] = v.z; p[3] = v.w; }
    __syncthreads();
    const int col = t & 31, kq = t >> 5;
#pragma unroll 1
    for (int b = 0; b < 9; ++b) { const int bit = 1 << b;
        const int m = (b == 5) ? 56 : (b == 6) ? 120 : bit;
#pragma unroll 8
        for (int j = 0; j < 16; ++j) { const int idx = j * 16 + kq, k = ((idx >> b) << (b + 1)) | (idx & (bit - 1)); LAS float* p0 = L + k * 33 + col; LAS float* p1 = L + (k ^ m) * 33 + col; const float a = *p0, c = *p1; *p0 = a + c; *p1 = a - c; }
        __syncthreads(); }
#pragma unroll
    for (int j = 0; j < 8; ++j) { const int k = r0 + 64 * j; const LAS float* p = L + k * 33 + 4 * c4; *(GAS f32x4*)(O + (size_t)k * D + 4 * c4) = (f32x4){p[0], p[1], p[2], p[3]} * 0.04419417382415922f; }
    __syncthreads();
}
constexpr int S_GU = 176, S_EGU = 88, NSLAB_GU = 2 * S_GU + 16 * S_EGU;
constexpr int S_ED = 64, S_DD = 128, S_IN = 120, S_OUT = 64, NSLAB = 8 * S_ED + S_DD + 2 * S_IN + 2 * S_OUT + NSLAB_GU;
__device__ __forceinline__ void rowquant_phase(const Args& A, const Frame& F, const float* xa);
__device__ __forceinline__ void p0_prologue(const Args& A, const Frame& F) {
    unsigned char* ws = A.ws; unsigned* cm = (unsigned*)(ws + WS_CMAX);
    { float* wof = (float*)(ws + WS_WOF);
#pragma unroll 1
      for (int q = blockIdx.x; q < 2 * 2 * 64; q += F.G) { const int l = q >> 7, g = (q >> 6) & 1, n0 = 32 * (q & 63), kb = 1024 + 512 * g;
          wht_panel(A.in[13] + (size_t)l * D * D + (size_t)kb * D + n0, A.in[12] + l * D + kb, wof + (size_t)l * D * D + (size_t)kb * D + n0, F); }
      { constexpr int NCP = 2 * 1024 * (D / 4); const int stride = F.G * 512; int o = blockIdx.x * 512 + F.tid;
#define WCP_IDX(o_, l_, k_, c_) const int l_ = (o_) / (1024 * (D / 4)), r_##l_ = (o_) % (1024 * (D / 4)), k_ = r_##l_ / (D / 4), c_ = r_##l_ % (D / 4)
        for (; o + 3 * stride < NCP; o += 4 * stride) { f32x4 v[4]; float g[4];
#pragma unroll
            for (int q = 0; q < 4; ++q) { WCP_IDX(o + q * stride, l, k, c); v[q] = *(const GAS f32x4*)(A.in[13] + (size_t)l * D * D + (size_t)k * D + 4 * c); g[q] = A.in[12][l * D + k]; }
#pragma unroll
            for (int q = 0; q < 4; ++q) { WCP_IDX(o + q * stride, l, k, c); *(GAS f32x4*)(wof + (size_t)l * D * D + (size_t)k * D + 4 * c) = v[q] * g[q]; } }
        for (; o < NCP; o += stride) { WCP_IDX(o, l, k, c); *(GAS f32x4*)(wof + (size_t)l * D * D + (size_t)k * D + 4 * c) = *(const GAS f32x4*)(A.in[13] + (size_t)l * D * D + (size_t)k * D + 4 * c) * A.in[12][l * D + k]; }
#undef WCP_IDX
      } }
#pragma unroll 1
    for (int q = blockIdx.x; q < 8 * S_ED; q += F.G) { const int e = q / S_ED, n0 = 32 * (q % S_ED);
        quant_slab<2816, 32, false>(A.in[21] + (size_t)e * DE * D + n0, D, nullptr, (signed char*)(ws + WS_ED) + (size_t)e * D * DE + (size_t)n0 * DE, cm + CM_ED + e * D + n0, F); }
#pragma unroll 1
    for (int q = blockIdx.x; q < S_DD; q += F.G) { const int n0 = 16 * q;
        quant_slab<5632, 16, false>(A.in[17] + n0, D, nullptr, (signed char*)(ws + WS_WD) + (size_t)n0 * DFF, cm + CM_D + n0, F); }
#pragma unroll 1
    for (int q = (blockIdx.x + F.G - (S_DD % F.G)) % F.G; q < (2 * S_IN + NSLAB_GU) / 2; q += F.G) {
        const float* src; int N; const float* gain; signed char* dst; unsigned* cmb;
        if (q < S_IN) { const int l = q / (S_IN / 2), n0 = 64 * (q % (S_IN / 2)); src = A.in[2] + (size_t)l * D * DIN + n0; N = DIN; gain = A.in[1] + l * D; dst = (signed char*)(ws + WS_WIN) + (size_t)l * DIN * D + (size_t)n0 * D; cmb = cm + CM_IN + l * DIN + n0; }
        else { const int q3 = q - S_IN; int il, sl; const float* s0; signed char* d0; unsigned* c0;
            if (q3 < S_GU) { const int w_ = q3 / (S_GU / 2); s0 = A.in[15 + w_]; N = DFF; gain = A.in[14]; il = w_; c0 = cm + CM_GU; d0 = (signed char*)(ws + WS_WGU); sl = q3 % (S_GU / 2); }
            else { const int r2 = q3 - S_GU, w_ = r2 / (8 * (S_EGU / 2)), e_ = (r2 / (S_EGU / 2)) % 8; s0 = A.in[19 + w_] + (size_t)e_ * D * DE; N = DE; gain = A.in[14] + D; il = w_; c0 = cm + CM_EGU + e_ * 2 * DE; d0 = (signed char*)(ws + WS_EGU) + (size_t)e_ * 2 * DE * D; sl = r2 % (S_EGU / 2); }
            const int n0 = 64 * sl, drow0 = 256 * (n0 >> 7) + 128 * il + (n0 & 127); src = s0 + n0; dst = d0 + (size_t)drow0 * D; cmb = c0 + drow0; }
        quant_slab<2048, 64, true>(src, N, gain, dst, cmb, F);
    }
    for (int o = blockIdx.x * 512 + F.tid; o < 2 * 8 * 64 * 64; o += F.G * 512) { const int i = o & 63, j = (o >> 6) & 63, lh = o >> 12; const size_t src = ((size_t)lh * 64 + i) * 64 + j;
        ((bf16*)(ws + WS_WAT))[o] = (bf16)f2bf(A.in[7][src]); ((bf16*)(ws + WS_WXT))[o] = (bf16)f2bf(A.in[9][src]); }
    for (int o = blockIdx.x * 512 + F.tid; o < D * 8; o += F.G * 512) { const int k = o >> 3, e = o & 7; const float v = A.in[18][o] * A.in[14][D + k];
        const unsigned hi_ = f2bf(v); const float r_ = v - __builtin_bit_cast(float, hi_ << 16); ((bf16*)(ws + WS_RWT))[e * D + k] = (bf16)hi_; ((bf16*)(ws + WS_RWT))[8 * D + e * D + k] = (bf16)f2bf(r_); }
    rowquant_phase(A, F, A.in[0]);
}
__device__ __forceinline__ void rowquant_phase(const Args& A, const Frame& F, const float* xa) {
    const int gw = blockIdx.x * NWAVES + F.wave, NGW = F.G * NWAVES, lane = F.lane;
    signed char* xq = (signed char*)(A.ws + WS_XQ8); float* as = (float*)(A.ws + WS_AS); bf16* xb = (bf16*)(A.ws + WS_XB);
    f32x4 nv[8];
    { const GAS f32x4* xr = (const GAS f32x4*)(xa + (size_t)(gw < T ? gw : 0) * D) + lane;
#pragma unroll
      for (int j = 0; j < 8; ++j) nv[j] = xr[64 * j]; }
    for (int m = gw; m < T; m += NGW) {
        f32x4 v[8]; float q = 0.f, mx = 0.f;
#pragma unroll
        for (int j = 0; j < 8; ++j) v[j] = nv[j];
        { const GAS f32x4* xr = (const GAS f32x4*)(xa + (size_t)(m + NGW < T ? m + NGW : m) * D) + lane;
#pragma unroll
          for (int j = 0; j < 8; ++j) nv[j] = xr[64 * j]; }
#pragma unroll
        for (int j = 0; j < 8; ++j) { q += (v[j].x * v[j].x + v[j].y * v[j].y) + (v[j].z * v[j].z + v[j].w * v[j].w);
            mx = fmaxf(fmaxf(mx, fmaxf(fabsf(v[j].x), fabsf(v[j].y))), fmaxf(fabsf(v[j].z), fabsf(v[j].w))); }
        q = wave_sum(q);
#pragma unroll
        for (int o = 1; o < 64; o <<= 1) mx = fmaxf(mx, __shfl_xor(mx, o));
        mx = fmaxf(mx, 1e-30f); const float inv = 127.f / mx;
        GAS unsigned* o4 = (GAS unsigned*)(xq + (size_t)m * D) + lane; GAS v2u* ob = (GAS v2u*)(xb + (size_t)m * D) + lane;
#pragma unroll
        for (int j = 0; j < 8; ++j) { ob[64 * j] = (v2u){pk2(v[j].x, v[j].y), pk2(v[j].z, v[j].w)}; const int a0 = (int)__builtin_rintf(v[j].x * inv), a1 = (int)__builtin_rintf(v[j].y * inv), a2 = (int)__builtin_rintf(v[j].z * inv), a3 = (int)__builtin_rintf(v[j].w * inv);
            o4[64 * j] = ((unsigned)a0 & 255u) | (((unsigned)a1 & 255u) << 8) | (((unsigned)a2 & 255u) << 16) | ((unsigned)a3 << 24); }
        if (lane == 0) as[m] = mx * (1.f / 127.f) * rsqrtf(q * (1.f / D) + EPS);
    }
}

template <int NCOL, int VEC> __device__ __forceinline__ void actquant_phase(const Frame& F, const bf16* src, signed char* dst, float* sc, const float* gws, int nrows) {
    constexpr int CH = NCOL / VEC / 64, NW32 = VEC / 2;
    static_assert(NCOL % (VEC * 64) == 0, "act row geometry");
    const int gw = blockIdx.x * NWAVES + F.wave, NGW = F.G * NWAVES, lane = F.lane;
    unsigned wn[CH][NW32];
#define AQ_LOAD(m_) do { const int mm_ = ((m_) < nrows) ? (m_) : gw; _Pragma("unroll") for (int j = 0; j < CH; ++j) { \
        if constexpr (VEC == 8) { const v4u r = ((const GAS v4u*)(src + (size_t)mm_ * NCOL))[lane + 64 * j]; wn[j][0] = r.x; wn[j][1] = r.y; wn[j][2] = r.z; wn[j][3] = r.w; } \
        else { const v2u r = ((const GAS v2u*)(src + (size_t)mm_ * NCOL))[lane + 64 * j]; wn[j][0] = r.x; wn[j][1] = r.y; } } } while (0)
    if (gw < nrows) AQ_LOAD(gw);
    float gn = (gws && gw < nrows) ? gws[gw] : 1.f;
    for (int m = gw; m < nrows; m += NGW) {
        unsigned w[CH][NW32]; float mx = 0.f; const float gcur = gn;
#pragma unroll
        for (int j = 0; j < CH; ++j)
#pragma unroll
            for (int i = 0; i < NW32; ++i) w[j][i] = wn[j][i];
        AQ_LOAD(m + NGW);
        gn = (gws && m + NGW < nrows) ? gws[m + NGW] : 1.f;
#pragma unroll
        for (int j = 0; j < CH; ++j)
#pragma unroll
            for (int i = 0; i < NW32; ++i) mx = fmaxf(mx, fmaxf(fabsf(bflo(w[j][i])), fabsf(bfhi(w[j][i]))));
#pragma unroll
        for (int o = 1; o < 64; o <<= 1) mx = fmaxf(mx, __shfl_xor(mx, o));
        mx = fmaxf(mx, 1e-30f); const float inv = 127.f / mx;
#pragma unroll
        for (int j = 0; j < CH; ++j) { unsigned o[NW32 / 2];
#pragma unroll
            for (int i = 0; i < NW32 / 2; ++i) { const int a0 = (int)__builtin_rintf(bflo(w[j][2 * i]) * inv), a1 = (int)__builtin_rintf(bfhi(w[j][2 * i]) * inv), a2 = (int)__builtin_rintf(bflo(w[j][2 * i + 1]) * inv), a3 = (int)__builtin_rintf(bfhi(w[j][2 * i + 1]) * inv);
                o[i] = ((unsigned)a0 & 255u) | (((unsigned)a1 & 255u) << 8) | (((unsigned)a2 & 255u) << 16) | ((unsigned)a3 << 24); }
            if constexpr (VEC == 8) { v2u ov; ov.x = o[0]; ov.y = o[1]; ((GAS v2u*)(dst + (size_t)m * NCOL))[lane + 64 * j] = ov; }
            else ((GAS unsigned*)(dst + (size_t)m * NCOL))[lane + 64 * j] = o[0]; }
        if (lane == 0) sc[m] = mx * (1.f / 127.f) * gcur;
    }
#undef AQ_LOAD
}

__device__ __forceinline__ void rowquant16_phase(const Args& A, const Frame& F, const bf16* xa) {
    const int gw = blockIdx.x * NWAVES + F.wave, NGW = F.G * NWAVES, lane = F.lane;
    signed char* xq = (signed char*)(A.ws + WS_XQ8); float* as = (float*)(A.ws + WS_AS);
    v4u nv[2][4];
#define RQ_LOAD(m0_) do { const int a_ = ((m0_) < T) ? (m0_) : gw, b_ = ((m0_) + NGW < T) ? (m0_) + NGW : a_; _Pragma("unroll") for (int r = 0; r < 2; ++r) { const GAS v4u* xr = (const GAS v4u*)(xa + (size_t)(r ? b_ : a_) * D) + lane; \
        _Pragma("unroll") for (int j = 0; j < 4; ++j) nv[r][j] = xr[64 * j]; } } while (0)
    if (gw < T) RQ_LOAD(gw);
    for (int m0 = gw; m0 < T; m0 += 2 * NGW) {
        const int m1 = (m0 + NGW < T) ? m0 + NGW : m0;
        v4u v[2][4];
#pragma unroll
        for (int r = 0; r < 2; ++r)
#pragma unroll
            for (int j = 0; j < 4; ++j) v[r][j] = nv[r][j];
        RQ_LOAD(m0 + 2 * NGW);
#pragma unroll
        for (int r = 0; r < 2; ++r) { const int m = r ? m1 : m0; float q = 0.f, mx = 0.f;
#pragma unroll
            for (int j = 0; j < 4; ++j) { const unsigned ww[4] = {v[r][j].x, v[r][j].y, v[r][j].z, v[r][j].w};
#pragma unroll
                for (int i = 0; i < 4; ++i) { const float a = bflo(ww[i]), b = bfhi(ww[i]); q += a * a + b * b; mx = fmaxf(mx, fmaxf(fabsf(a), fabsf(b))); } }
            q = wave_sum(q);
#pragma unroll
            for (int o = 1; o < 64; o <<= 1) mx = fmaxf(mx, __shfl_xor(mx, o));
            mx = fmaxf(mx, 1e-30f); const float inv = 127.f / mx;
            GAS v2u* o8 = (GAS v2u*)(xq + (size_t)m * D) + lane;
#pragma unroll
            for (int j = 0; j < 4; ++j) { const unsigned ww[4] = {v[r][j].x, v[r][j].y, v[r][j].z, v[r][j].w}; unsigned o[2];
#pragma unroll
                for (int i = 0; i < 2; ++i) { const int a0 = (int)__builtin_rintf(bflo(ww[2 * i]) * inv), a1 = (int)__builtin_rintf(bfhi(ww[2 * i]) * inv), a2 = (int)__builtin_rintf(bflo(ww[2 * i + 1]) * inv), a3 = (int)__builtin_rintf(bfhi(ww[2 * i + 1]) * inv);
                    o[i] = ((unsigned)a0 & 255u) | (((unsigned)a1 & 255u) << 8) | (((unsigned)a2 & 255u) << 16) | ((unsigned)a3 << 24); }
                o8[64 * j] = (v2u){o[0], o[1]}; }
            if (lane == 0) as[m] = mx * (1.f / 127.f) * rsqrtf(q * (1.f / D) + EPS); }
    }
#undef RQ_LOAD
}

__device__ __forceinline__ void wout_quant(const Args& A, const Frame& F) {
    unsigned char* ws = A.ws;
#pragma unroll 1
    for (int q = (int)((blockIdx.x + 64) % F.G); q < 64; q += F.G) { const int l = q >> 5, n0 = 64 * (q & 31);
        quant_slab<2048, 64, false>((const float*)(ws + WS_WOF) + (size_t)l * D * D + n0, D, nullptr, (signed char*)(ws + WS_WOUT) + (size_t)l * D * D + (size_t)n0 * D, (unsigned*)(ws + WS_CMAX) + CM_OUT + l * D + n0, F); }
}
__device__ __forceinline__ void attn_unit(const Frame& F, int unit, const bf16* proj, bf16* amix, float* ssqa, const float* sinks) {
    const int b = unit >> 6, nb = (unit >> 1) & 31, kvh = unit & 1;
    const int tok0 = b * SEQ + nb * 128;
    LAS bf16* Ks = (LAS bf16*)(F.lds);
    LAS bf16* Vt = (LAS bf16*)(F.lds + 36864);
    const int h = kvh * 8 + F.wave, lane = F.lane, ql = lane & 31, hi = lane >> 5;
    bf16x8 qf[4], qn[4];
#pragma unroll
    for (int ks = 0; ks < 4; ++ks) qf[ks] = *(const GAS bf16x8*)(proj + ((size_t)tok0 + ql) * DIN + C_Q + h * 64 + 16 * ks + 8 * hi);
    v4u kq[4], vq[4];
#pragma unroll
    for (int it = 0; it < 4; ++it) { const int i = F.tid + 512 * it, kw = i >> 3, c = i & 7; const bf16* rp = proj + ((size_t)tok0 + kw - 128) * DIN; kq[it] = *(const GAS v4u*)(rp + C_K + kvh * 64 + c * 8); vq[it] = *(const GAS v4u*)(rp + C_V + kvh * 64 + c * 8); }
    __builtin_amdgcn_sched_barrier(0);
#pragma unroll
    for (int it = 0; it < 4; ++it) { const int i = F.tid + 512 * it;
        const int kw = i >> 3, c = i & 7; const bool valid = (nb > 0) || (kw >= 128);
        v4u kv = kq[it], vv = vq[it];
        kv.x = valid ? kv.x : 0u; kv.y = valid ? kv.y : 0u; kv.z = valid ? kv.z : 0u; kv.w = valid ? kv.w : 0u; vv.x = valid ? vv.x : 0u; vv.y = valid ? vv.y : 0u; vv.z = valid ? vv.z : 0u; vv.w = valid ? vv.w : 0u;
        *(LAS v4u*)(Ks + kw * 72 + c * 8) = kv;
        LAS bf16* vp = Vt + (c * 8) * 264 + kw;
        vp[0 * 264] = (bf16)(vv.x & 0xffffu); vp[1 * 264] = (bf16)(vv.x >> 16); vp[2 * 264] = (bf16)(vv.y & 0xffffu); vp[3 * 264] = (bf16)(vv.y >> 16);
        vp[4 * 264] = (bf16)(vv.z & 0xffffu); vp[5 * 264] = (bf16)(vv.z >> 16); vp[6 * 264] = (bf16)(vv.w & 0xffffu); vp[7 * 264] = (bf16)(vv.w >> 16);
    }
    __syncthreads();
    const float sink2 = sinks[h] * LOG2E; const float SC = 0.125f * LOG2E; const float NEG = -__builtin_inff();
#pragma unroll
    for (int ks = 0; ks < 4; ++ks) qn[ks] = qf[ks];
#pragma unroll 1
    for (int qs = 0; qs < 128; qs += 32) {
        const size_t tq = (size_t)tok0 + qs + ql;
        if (qs + 32 < 128) {
#pragma unroll
            for (int ks = 0; ks < 4; ++ks) qn[ks] = *(const GAS bf16x8*)(proj + (tq + 32) * DIN + C_Q + h * 64 + 16 * ks + 8 * hi); }
        f32x16 s[5];
#pragma unroll
        for (int kt = 0; kt < 5; ++kt) { f32x16 a = {};
#pragma unroll
            for (int ks = 0; ks < 4; ++ks) { const bf16x8 kf = *(const LAS bf16x8*)(Ks + (qs + 32 * kt + ql) * 72 + 16 * ks + 8 * hi); a = MFMA32(kf, qf[ks], a); }
            s[kt] = a; }
#pragma unroll
        for (int i = 0; i < 16; ++i) { const int kk = (i & 3) + 8 * (i >> 2) + 4 * hi; s[0][i] = (kk > ql) ? s[0][i] : NEG; s[4][i] = (kk <= ql) ? s[4][i] : NEG; }
        if (nb == 0) {
#pragma unroll
            for (int kt = 0; kt < 5; ++kt)
#pragma unroll
                for (int i = 0; i < 16; ++i) { const int kw = qs + 32 * kt + (i & 3) + 8 * (i >> 2) + 4 * hi; s[kt][i] = (kw >= 128) ? s[kt][i] : NEG; } }
        float mr = NEG;
#pragma unroll
        for (int kt = 0; kt < 5; ++kt)
#pragma unroll
            for (int i = 0; i < 16; i += 2) mr = fmaxf(fmaxf(mr, s[kt][i]), s[kt][i + 1]);
        mr = fmaxf(mr, __shfl_xor(mr, 32));
        const float mx = fmaxf(mr * SC, sink2);
        float sum = 0.f;
#pragma unroll
        for (int kt = 0; kt < 5; ++kt)
#pragma unroll
            for (int i = 0; i < 16; ++i) { const float p = __builtin_amdgcn_exp2f(__builtin_fmaf(s[kt][i], SC, -mx)); s[kt][i] = p; sum += p; }
        sum += __shfl_xor(sum, 32);
        const float inv = 1.f / (sum + __builtin_amdgcn_exp2f(sink2 - mx));
        f32x16 o[2]; o[0] = (f32x16){}; o[1] = (f32x16){};
#pragma unroll
        for (int kt = 0; kt < 5; ++kt)
#pragma unroll
            for (int st = 0; st < 2; ++st) {
                v4u pw; pw.x = pk2(s[kt][8 * st + 0], s[kt][8 * st + 1]); pw.y = pk2(s[kt][8 * st + 2], s[kt][8 * st + 3]); pw.z = pk2(s[kt][8 * st + 4], s[kt][8 * st + 5]); pw.w = pk2(s[kt][8 * st + 6], s[kt][8 * st + 7]);
                const bf16x8 pf = __builtin_bit_cast(bf16x8, pw);
                const int kbase = qs + 32 * kt + 16 * st + 4 * hi;
#pragma unroll
                for (int dt = 0; dt < 2; ++dt) { const LAS bf16* vp = Vt + (dt * 32 + ql) * 264 + kbase; const v2u lo = *(const LAS v2u*)vp, hi8 = *(const LAS v2u*)(vp + 8);
                    v4u vw; vw.x = lo.x; vw.y = lo.y; vw.z = hi8.x; vw.w = hi8.y; o[dt] = MFMA32(__builtin_bit_cast(bf16x8, vw), pf, o[dt]); }
            }
        float q = 0.f;
#pragma unroll
        for (int dt = 0; dt < 2; ++dt)
#pragma unroll
            for (int g4 = 0; g4 < 4; ++g4) { const float v0 = o[dt][4 * g4] * inv, v1 = o[dt][4 * g4 + 1] * inv, v2 = o[dt][4 * g4 + 2] * inv, v3 = o[dt][4 * g4 + 3] * inv;
                q += (v0 * v0 + v1 * v1) + (v2 * v2 + v3 * v3); v2u w; w.x = pk2(v0, v1); w.y = pk2(v2, v3);
                *(GAS v2u*)(amix + tq * 1024 + h * 64 + dt * 32 + 8 * g4 + 4 * hi) = w; }
        q += __shfl_xor(q, 32);
        if (hi == 0) ssqa[tq * 16 + h] = q;
#pragma unroll
        for (int ks = 0; ks < 4; ++ks) qf[ks] = qn[ks];
    }
    __syncthreads();
}

__device__ __forceinline__ float gelu_tanh(float x) { const float z = 0.7978845608028654f * (x + 0.044715f * x * x * x); return x * sigmoidf_(2.f * z); }
template <int MODE> __device__ __forceinline__ void lru_chunk(const Args& A, const Frame& F, int unit, int layer, const bf16* proj, float2* lsum, float (&y)[64]) {
    constexpr bool FULL = (MODE == 1), ONE = (MODE == 2);
    const int b = unit >> 6, c64 = unit & 63, hh = F.wave, lane = F.lane, tl = lane & 31, hi = lane >> 5;
    const int ch0 = hh * 64, s0 = c64 * 64; const size_t t0 = (size_t)b * SEQ + s0;
    LAS float* XA = (LAS float*)(F.lds + hh * LRU_WREG); LAS float* U = XA + 32 * 68;
    const float* cw = A.in[5] + layer * 4 * 512; const float* cbias = A.in[6] + layer * 512;
    const float* ba = A.in[8] + layer * 512; const float* bx = A.in[10] + layer * 512; const float* lam = A.in[11] + layer * 512;
    const bf16* wat = (const bf16*)(A.ws + WS_WAT) + (size_t)(layer * 8 + hh) * 4096; const bf16* wxt = (const bf16*)(A.ws + WS_WXT) + (size_t)(layer * 8 + hh) * 4096;
    float nba0 = 0.f, nba1 = 0.f, nbx0 = 0.f, nbx1 = 0.f, sp0 = 0.f, sp1 = 0.f;
    if constexpr (MODE == 0) { nba0 = -LOG2E * ba[ch0 + tl]; nba1 = -LOG2E * ba[ch0 + 32 + tl]; nbx0 = -LOG2E * bx[ch0 + tl]; nbx1 = -LOG2E * bx[ch0 + 32 + tl];
        sp0 = -8.f * LOG2E * log1pf(__expf(-lam[ch0 + tl])); sp1 = -8.f * LOG2E * log1pf(__expf(-lam[ch0 + 32 + tl])); }
    float h = 0.f, P = 1.f;
    if (FULL) { const float2* lp = lsum + (size_t)(b * 64) * 512 + ch0 + lane;
#pragma unroll 1
        for (int j0 = 0; j0 < c64; j0 += 16) { float2 sm[16];
#pragma unroll
            for (int i = 0; i < 16; ++i) sm[i] = (j0 + i < c64) ? lp[(size_t)(j0 + i) * 512] : make_float2(1.f, 0.f);
#pragma unroll
            for (int i = 0; i < 16; ++i) h = sm[i].x * h + sm[i].y; } }
#pragma unroll
    for (int tt = 0; tt < 2; ++tt) {
        { LAS unsigned char* LX = (LAS unsigned char*)U;
          LAS float* CW = (LAS float*)(LX + 35 * 144);
          v4u lv[5]; float cv[5];
#pragma unroll
          for (int it = 0; it < 5; ++it) { const int i = (lane + 64 * it < 35 * 8) ? lane + 64 * it : 35 * 8 - 1; const int row = i >> 3, c = i & 7;
                lv[it] = *(const GAS v4u*)(proj + (t0 + 32 * tt - 3 + row) * DIN + C_LX + ch0 + 8 * c); }
#pragma unroll
          for (int k = 0; k < 4; ++k) cv[k] = cw[k * 512 + ch0 + lane];
          cv[4] = cbias[ch0 + lane];
          __builtin_amdgcn_sched_barrier(0);
#pragma unroll
          for (int it = 0; it < 5; ++it) { const int i = lane + 64 * it; if (i < 35 * 8) { const int row = i >> 3, c = i & 7; const bool ok = (s0 + 32 * tt - 3 + row >= 0);
                v4u v = lv[it]; v.x = ok ? v.x : 0u; v.y = ok ? v.y : 0u; v.z = ok ? v.z : 0u; v.w = ok ? v.w : 0u;
                *(LAS v4u*)(LX + row * 144 + 16 * c) = v; } }
#pragma unroll
          for (int k = 0; k < 5; ++k) CW[k * 64 + lane] = cv[k];
          LDS_WAIT();
#pragma unroll 1
          for (int ks = 0; ks < 4; ++ks) { const int cb8 = 16 * ks + 8 * hi;
            float a8[8];
            { const f32x4 b0 = *(const LAS f32x4*)(CW + 4 * 64 + cb8), b1 = *(const LAS f32x4*)(CW + 4 * 64 + cb8 + 4); a8[0] = b0.x; a8[1] = b0.y; a8[2] = b0.z; a8[3] = b0.w; a8[4] = b1.x; a8[5] = b1.y; a8[6] = b1.z; a8[7] = b1.w; }
#pragma unroll
            for (int k = 0; k < 4; ++k) { const v4u raw = *(const LAS v4u*)(LX + (tl + 3 - k) * 144 + 2 * cb8);
                const f32x4 w0 = *(const LAS f32x4*)(CW + k * 64 + cb8), w1 = *(const LAS f32x4*)(CW + k * 64 + cb8 + 4);
                a8[0] += w0.x * bflo(raw.x); a8[1] += w0.y * bfhi(raw.x); a8[2] += w0.z * bflo(raw.y); a8[3] += w0.w * bfhi(raw.y);
                a8[4] += w1.x * bflo(raw.z); a8[5] += w1.y * bfhi(raw.z); a8[6] += w1.z * bflo(raw.w); a8[7] += w1.w * bfhi(raw.w); }
            LAS float* xp = XA + tl * 68 + cb8;
            *(LAS f32x4*)xp = (f32x4){a8[0], a8[1], a8[2], a8[3]}; *(LAS f32x4*)(xp + 4) = (f32x4){a8[4], a8[5], a8[6], a8[7]}; } }
        LDS_WAIT();
        bf16x8 af[4];
#pragma unroll
        for (int ks = 0; ks < 4; ++ks) { const LAS float* xp = XA + tl * 68 + 16 * ks + 8 * hi; const f32x4 x0 = *(const LAS f32x4*)xp, x1 = *(const LAS f32x4*)(xp + 4);
            v4u pw; pw.x = pk2(x0.x, x0.y); pw.y = pk2(x0.z, x0.w); pw.z = pk2(x1.x, x1.y); pw.w = pk2(x1.z, x1.w); af[ks] = __builtin_bit_cast(bf16x8, pw); }
        LDS_WAIT();
#pragma unroll 1
        for (int jt = 0; jt < 2; ++jt) { const int j = 32 * jt + tl; f32x16 ra = {}, ia = {};
#pragma unroll
            for (int ks = 0; ks < 4; ++ks) { const bf16x8 bw = *(const GAS bf16x8*)(wat + j * 64 + 16 * ks + 8 * hi), bv = *(const GAS bf16x8*)(wxt + j * 64 + 16 * ks + 8 * hi);
                ra = MFMA32(af[ks], bw, ra); ia = MFMA32(af[ks], bv, ia); }
            float nba_j, nbx_j, sp_j;
            if constexpr (FULL || ONE) { nba_j = -LOG2E * ba[ch0 + j]; nbx_j = -LOG2E * bx[ch0 + j]; sp_j = -8.f * LOG2E * log1pf(__expf(-lam[ch0 + j])); }
            else { nba_j = jt ? nba1 : nba0; nbx_j = jt ? nbx1 : nbx0; sp_j = jt ? sp1 : sp0; }
#pragma unroll
            for (int r = 0; r < 16; ++r) { const int tok = (r & 3) + 8 * (r >> 2) + 4 * hi; const float xcv = XA[tok * 68 + j];
                const float rr = __builtin_amdgcn_rcpf(1.f + __builtin_amdgcn_exp2f(__builtin_fmaf(ra[r], -LOG2E, nba_j))), ii = __builtin_amdgcn_rcpf(1.f + __builtin_amdgcn_exp2f(__builtin_fmaf(ia[r], -LOG2E, nbx_j)));
                const float a = __builtin_amdgcn_exp2f(rr * sp_j); const float u = __builtin_amdgcn_sqrtf(fmaxf(1.f - a * a, 0.f)) * ii * xcv;
                XA[tok * 68 + j] = a; U[tok * 68 + j] = u; } }
        LDS_WAIT();
        bf16 lgr[32];
        if constexpr (FULL) {
#pragma unroll
            for (int t = 0; t < 32; ++t) lgr[t] = proj[(t0 + 32 * tt + t) * DIN + C_LG + ch0 + lane];
            __builtin_amdgcn_sched_barrier(0); }
#pragma unroll
        for (int t = 0; t < 32; ++t) { const float a = XA[t * 68 + lane], u = U[t * 68 + lane]; h = a * h + u; P *= a;
            if constexpr (FULL) { y[32 * tt + t] = h * gelu_tanh(bf1(lgr[t])); }
            if constexpr (ONE) { unsigned pw_ = pk2(h, P); asm volatile("" : "+v"(pw_)); y[32 * tt + t] = __uint_as_float(pw_); } }
        LDS_WAIT();
    }
    if constexpr (MODE == 0) lsum[(size_t)(b * 64 + c64) * 512 + ch0 + lane] = make_float2(P, h);
    if constexpr (ONE) {
        typedef GAS unsigned long long gu64_;
        asm volatile("" ::: "memory"); __builtin_amdgcn_sched_barrier(0);
        int lnt = lane; asm volatile("" : "+v"(lnt));
        __hip_atomic_store((gu64_*)(lsum + (size_t)(b * 64 + c64) * 512 + ch0 + lnt), ((unsigned long long)__float_as_uint(h) << 32) | (unsigned long long)__float_as_uint(P), __ATOMIC_RELAXED, __HIP_MEMORY_SCOPE_AGENT);
        bf16 lgr[64];
        const __amdgpu_buffer_rsrc_t prs = __builtin_amdgcn_make_buffer_rsrc((void*)proj, 0, 0x7ffffff0, 0x00020000);
        const unsigned lgo = (unsigned)((t0 * DIN + C_LG + ch0 + lnt) * 2);
#pragma unroll
        for (int t = 0; t < 64; ++t) lgr[t] = (bf16)__builtin_amdgcn_raw_buffer_load_b16(prs, lgo, (unsigned)(t * DIN * 2), 0);
        asm volatile("s_waitcnt vmcnt(0)" ::: "memory");
        __syncthreads();
        if (F.tid == 0) { gu64_* flag = (gu64_*)(A.ws + WS_CTL) + (CW_FLOW / 2) + (layer * 4 + b) * 32;
            (void)__hip_atomic_fetch_or(flag, 1ull << c64, __ATOMIC_RELAXED, __HIP_MEMORY_SCOPE_AGENT);
            const unsigned long long need = (1ull << c64) - 1ull; unsigned sp_ = 0;
            while ((__hip_atomic_load(flag, __ATOMIC_RELAXED, __HIP_MEMORY_SCOPE_AGENT) & need) != need) { __builtin_amdgcn_s_sleep(1); if (++sp_ > XB_SPIN_CAP) break; }
            __builtin_amdgcn_fence(__ATOMIC_ACQUIRE, "agent"); }
        __syncthreads();
        float carry = 0.f;
        { int ln_ = lnt; const float2* lp = lsum + (size_t)(b * 64) * 512 + ch0 + ln_;
#pragma unroll 1
          for (int j0 = 0; j0 < c64; j0 += 32) { float2 sm[32];
#pragma unroll
              for (int i = 0; i < 32; ++i) sm[i] = (j0 + i < c64) ? lp[(size_t)(j0 + i) * 512] : make_float2(1.f, 0.f);
#pragma unroll
              for (int i = 0; i < 32; ++i) carry = sm[i].x * carry + sm[i].y; } }
#pragma unroll
        for (int t = 0; t < 32; ++t) { const unsigned w_ = __float_as_uint(y[t]); y[t] = (bflo(w_) + bfhi(w_) * carry) * gelu_tanh(bf1(lgr[t])); }
#pragma unroll
        for (int t = 0; t < 32; ++t) { const unsigned w_ = __float_as_uint(y[32 + t]); y[32 + t] = (bflo(w_) + bfhi(w_) * carry) * gelu_tanh(bf1(lgr[32 + t])); }
    }
}
template <int CTRL> __device__ __forceinline__ float dpp_get(float v) { return __builtin_bit_cast(float, __builtin_amdgcn_update_dpp(0, __builtin_bit_cast(int, v), CTRL, 0xF, 0xF, false)); }
__device__ __forceinline__ float wave_sum_all(float v) {
    v += dpp_get<0xB1>(v); v += dpp_get<0x4E>(v); v += dpp_get<0x141>(v); v += dpp_get<0x140>(v);
    { const auto rr = __builtin_amdgcn_permlane16_swap(__float_as_uint(v), __float_as_uint(v), false, false); v = __uint_as_float(rr[0]) + __uint_as_float(rr[1]); }
    { const auto rr = __builtin_amdgcn_permlane32_swap(__float_as_uint(v), __float_as_uint(v), false, false); v = __uint_as_float(rr[0]) + __uint_as_float(rr[1]); }
    return v;
}
__device__ __forceinline__ float wave_max_all(float v) {
    v = fmaxf(v, dpp_get<0xB1>(v)); v = fmaxf(v, dpp_get<0x4E>(v)); v = fmaxf(v, dpp_get<0x141>(v)); v = fmaxf(v, dpp_get<0x140>(v));
    { const auto rr = __builtin_amdgcn_permlane16_swap(__float_as_uint(v), __float_as_uint(v), false, false); v = fmaxf(__uint_as_float(rr[0]), __uint_as_float(rr[1])); }
    { const auto rr = __builtin_amdgcn_permlane32_swap(__float_as_uint(v), __float_as_uint(v), false, false); v = fmaxf(__uint_as_float(rr[0]), __uint_as_float(rr[1])); }
    return v;
}
__device__ __forceinline__ float row16_sum_all(float v) { v += dpp_get<0xB1>(v); v += dpp_get<0x4E>(v); v += dpp_get<0x141>(v); v += dpp_get<0x140>(v); return v; }
template <int CTRL> __device__ __forceinline__ void wht_dpp_stage(float (&v)[8], bool up) {
#pragma unroll
    for (int i = 0; i < 8; ++i) { const float p = dpp_get<CTRL>(v[i]); v[i] = up ? p - v[i] : v[i] + p; }
}
__device__ __forceinline__ void wht512(float (&v)[8], int lane) {
#pragma unroll
    for (int b = 0; b < 3; ++b)
#pragma unroll
        for (int i = 0; i < 8; ++i) if (!(i & (1 << b))) { const float a = v[i], c = v[i | (1 << b)]; v[i] = a + c; v[i | (1 << b)] = a - c; }
    wht_dpp_stage<0xB1>(v, lane & 1); wht_dpp_stage<0x4E>(v, lane & 2); wht_dpp_stage<0x141>(v, lane & 4); wht_dpp_stage<0x140>(v, lane & 8);
    { const float s16 = (lane & 16) ? -1.f : 1.f;
#pragma unroll
      for (int i = 0; i < 8; ++i) { const auto rr = __builtin_amdgcn_permlane16_swap(__float_as_uint(v[i]), __float_as_uint(v[i]), false, false); v[i] = __uint_as_float(rr[0]) + s16 * __uint_as_float(rr[1]); } }
    { const float s32 = (lane & 32) ? -0.04419417382415922f : 0.04419417382415922f;
#pragma unroll
      for (int i = 0; i < 8; ++i) { const auto rr = __builtin_amdgcn_permlane32_swap(__float_as_uint(v[i]), __float_as_uint(v[i]), false, false); v[i] = 0.04419417382415922f * __uint_as_float(rr[0]) + s32 * __uint_as_float(rr[1]); } }
}
__device__ __forceinline__ void mix_unit(const Args& A, const Frame& F, int unit, int layer, const bf16* proj, const bf16* amixb, signed char* amix8, float* asm_o, const float* ssqa, float2* lsum) {
    float y[64];
    lru_chunk<2>(A, F, unit, layer, proj, lsum, y);
    { LAS float* Yw = (LAS float*)(F.lds + F.wave * LRU_WREG);
#pragma unroll
      for (int t = 0; t < 64; ++t) Yw[t * 68 + F.lane] = y[t]; }
    __syncthreads();
    int lane_ = F.lane; asm volatile("" : "+v"(lane_));
    const int b = unit >> 6, c64 = unit & 63, lane = lane_, s0 = c64 * 64; const size_t t0 = (size_t)b * SEQ + s0;
    const float* cwp = A.in[4] + layer * 3 * 512 + lane * 8;
    float w0[8], w1[8], w2[8];
    { const f32x4 a0 = *(const GAS f32x4*)(cwp), a1 = *(const GAS f32x4*)(cwp + 4), b0 = *(const GAS f32x4*)(cwp + 512), b1 = *(const GAS f32x4*)(cwp + 516), c0 = *(const GAS f32x4*)(cwp + 1024), c1 = *(const GAS f32x4*)(cwp + 1028);
      w0[0] = a0.x; w0[1] = a0.y; w0[2] = a0.z; w0[3] = a0.w; w0[4] = a1.x; w0[5] = a1.y; w0[6] = a1.z; w0[7] = a1.w;
      w1[0] = b0.x; w1[1] = b0.y; w1[2] = b0.z; w1[3] = b0.w; w1[4] = b1.x; w1[5] = b1.y; w1[6] = b1.z; w1[7] = b1.w;
      w2[0] = c0.x; w2[1] = c0.y; w2[2] = c0.z; w2[3] = c0.w; w2[4] = c1.x; w2[5] = c1.y; w2[6] = c1.z; w2[7] = c1.w; }
    const int tokb = 8 * F.wave; const bool first = (s0 == 0);
    float p0[8], p1[8];
    { const bf16* r1 = proj + (t0 + tokb - 1) * DIN; const bf16* r2 = proj + (t0 + tokb - 2) * DIN;
      const v4u c1 = *(const GAS v4u*)(r1 + C_CC + lane * 8), x1 = *(const GAS v4u*)(r1 + C_CX + lane * 8), c2 = *(const GAS v4u*)(r2 + C_CC + lane * 8), x2 = *(const GAS v4u*)(r2 + C_CX + lane * 8);
      const bool z1 = first && tokb < 1, z2 = first && tokb < 2;
      p0[0] = bflo(c1.x) * bflo(x1.x); p0[1] = bfhi(c1.x) * bfhi(x1.x); p0[2] = bflo(c1.y) * bflo(x1.y); p0[3] = bfhi(c1.y) * bfhi(x1.y);
      p0[4] = bflo(c1.z) * bflo(x1.z); p0[5] = bfhi(c1.z) * bfhi(x1.z); p0[6] = bflo(c1.w) * bflo(x1.w); p0[7] = bfhi(c1.w) * bfhi(x1.w);
      p1[0] = bflo(c2.x) * bflo(x2.x); p1[1] = bfhi(c2.x) * bfhi(x2.x); p1[2] = bflo(c2.y) * bflo(x2.y); p1[3] = bfhi(c2.y) * bfhi(x2.y);
      p1[4] = bflo(c2.z) * bflo(x2.z); p1[5] = bfhi(c2.z) * bfhi(x2.z); p1[6] = bflo(c2.w) * bflo(x2.w); p1[7] = bfhi(c2.w) * bfhi(x2.w);
#pragma unroll
      for (int j = 0; j < 8; ++j) { p0[j] = z1 ? 0.f : p0[j]; p1[j] = z2 ? 0.f : p1[j]; } }
    v4u ncc, ncx, ncb, na0, na1; float nss;
#define MIX_LOAD(tt_) do { const size_t t_ = (tt_); const bf16* rp_ = proj + t_ * DIN; ncc = *(const GAS v4u*)(rp_ + C_CC + lane * 8); ncx = *(const GAS v4u*)(rp_ + C_CX + lane * 8); ncb = *(const GAS v4u*)(rp_ + C_CB + lane * 8); \
        na0 = *(const GAS v4u*)(amixb + t_ * 1024 + lane * 8); na1 = *(const GAS v4u*)(amixb + t_ * 1024 + 512 + lane * 8); nss = ssqa[t_ * 16 + (lane & 15)]; } while (0)
    MIX_LOAD(t0 + tokb);
#pragma unroll 4
    for (int i = 0; i < 8; ++i) { const int tok = tokb + i; const size_t t = t0 + tok;
        const v4u cc = ncc, cx = ncx, cbv = ncb, at0 = na0, at1 = na1; const float ssv = nss;
        MIX_LOAD(t0 + tokb + (i < 7 ? i + 1 : 7));
        float p2[8];
#pragma unroll
        for (int j = 0; j < 8; ++j) { p2[j] = p1[j]; p1[j] = p0[j]; }
        p0[0] = bflo(cc.x) * bflo(cx.x); p0[1] = bfhi(cc.x) * bfhi(cx.x); p0[2] = bflo(cc.y) * bflo(cx.y); p0[3] = bfhi(cc.y) * bfhi(cx.y);
        p0[4] = bflo(cc.z) * bflo(cx.z); p0[5] = bfhi(cc.z) * bfhi(cx.z); p0[6] = bflo(cc.w) * bflo(cx.w); p0[7] = bfhi(cc.w) * bfhi(cx.w);
        {
            float yc[8]; const float cbf[8] = {bflo(cbv.x), bfhi(cbv.x), bflo(cbv.y), bfhi(cbv.y), bflo(cbv.z), bfhi(cbv.z), bflo(cbv.w), bfhi(cbv.w)};
            float qc = 0.f;
#pragma unroll
            for (int j = 0; j < 8; ++j) { yc[j] = cbf[j] * (w0[j] * p0[j] + w1[j] * p1[j] + w2[j] * p2[j]); qc += yc[j] * yc[j]; }
            const LAS float* yr = (const LAS float*)(F.lds + (lane >> 3) * LRU_WREG) + tok * 68 + (lane & 7) * 8;
            const f32x4 y0 = *(const LAS f32x4*)yr, y1 = *(const LAS f32x4*)(yr + 4);
            float ql = (y0.x * y0.x + y0.y * y0.y) + (y0.z * y0.z + y0.w * y0.w) + (y1.x * y1.x + y1.y * y1.y) + (y1.z * y1.z + y1.w * y1.w);
            qc = wave_sum_all(qc); ql = wave_sum_all(ql);
            const float sa = row16_sum_all(ssv);
            const float ra_inv = sqrtf(sa * (1.f / 1024.f) + EPS);
            const float fc = rsqrtf(qc * (1.f / 512.f) + EPS) * ra_inv, fl = rsqrtf(ql * (1.f / 512.f) + EPS) * ra_inv;
            float yl[8] = {y0.x * fl, y0.y * fl, y0.z * fl, y0.w * fl, y1.x * fl, y1.y * fl, y1.z * fl, y1.w * fl};
#pragma unroll
            for (int j = 0; j < 8; ++j) yc[j] *= fc;
            wht512(yc, lane); wht512(yl, lane);
            const unsigned aw[8] = {at0.x, at0.y, at0.z, at0.w, at1.x, at1.y, at1.z, at1.w};
            float mx = 0.f;
#pragma unroll
            for (int j = 0; j < 8; ++j) { mx = fmaxf(mx, fmaxf(fabsf(yc[j]), fabsf(yl[j]))); mx = fmaxf(mx, fmaxf(fabsf(bflo(aw[j])), fabsf(bfhi(aw[j])))); }
            mx = wave_max_all(mx);
            mx = fmaxf(mx, 1e-30f); const float inv = 127.f / mx;
            unsigned qa[4], qc2[2], ql2[2];
#define Q8(x_) __float_as_uint(__builtin_fmaf((x_), inv, 12582912.f))
#define PK4(a_, b_, c_, d_) __builtin_amdgcn_perm(__builtin_amdgcn_perm((d_), (c_), 0x0c0c0400u), __builtin_amdgcn_perm((b_), (a_), 0x0c0c0400u), 0x05040100u)
#pragma unroll
            for (int j = 0; j < 4; ++j) qa[j] = PK4(Q8(bflo(aw[2 * j])), Q8(bfhi(aw[2 * j])), Q8(bflo(aw[2 * j + 1])), Q8(bfhi(aw[2 * j + 1])));
#pragma unroll
            for (int j = 0; j < 2; ++j) { qc2[j] = PK4(Q8(yc[4 * j]), Q8(yc[4 * j + 1]), Q8(yc[4 * j + 2]), Q8(yc[4 * j + 3])); ql2[j] = PK4(Q8(yl[4 * j]), Q8(yl[4 * j + 1]), Q8(yl[4 * j + 2]), Q8(yl[4 * j + 3])); }
#undef Q8
#undef PK4
            GAS v2u* orow = (GAS v2u*)(amix8 + t * D);
            orow[lane] = (v2u){qa[0], qa[1]}; orow[64 + lane] = (v2u){qa[2], qa[3]}; orow[128 + lane] = (v2u){qc2[0], qc2[1]}; orow[192 + lane] = (v2u){ql2[0], ql2[1]};
            if (lane == 0) asm_o[t] = mx * (1.f / 127.f) / ra_inv;
        }
    }
#undef MIX_LOAD
    __syncthreads();
}
template <int CTRL, int RM> __device__ __forceinline__ float dppf(float v) { return __builtin_bit_cast(float, __builtin_amdgcn_update_dpp(0, __builtin_bit_cast(int, v), CTRL, RM, 0xF, false)); }
__device__ __forceinline__ float wave_sum63(float v) { v += dppf<0xB1, 0xF>(v); v += dppf<0x4E, 0xF>(v); v += dppf<0x141, 0xF>(v); v += dppf<0x140, 0xF>(v); v += dppf<0x142, 0xA>(v); v += dppf<0x143, 0xC>(v); return v; }
__device__ __forceinline__ float wave_max63(float v) { v = fmaxf(v, dppf<0xB1, 0xF>(v)); v = fmaxf(v, dppf<0x4E, 0xF>(v)); v = fmaxf(v, dppf<0x141, 0xF>(v)); v = fmaxf(v, dppf<0x140, 0xF>(v)); v = fmaxf(v, dppf<0x142, 0xA>(v)); v = fmaxf(v, dppf<0x143, 0xC>(v)); return v; }
__device__ __forceinline__ void router_phase(const Args& A, const Frame& F, const bf16* xa) {
    unsigned char* ws = A.ws;
    const int lane = F.lane, w = F.wave;
    LAS float* RWL = (LAS float*)F.lds;
    LAS float* invs = (LAS float*)(F.lds + 65536);
    LAS unsigned* eblk = (LAS unsigned*)(F.lds + 65536 + 256);
    const float* gn = A.in[14] + D; const float* rw = A.in[18];
    float* as_o = (float*)(ws + WS_AS); signed char* xq = (signed char*)(ws + WS_XQ8); unsigned* toke = (unsigned*)(ws + WS_TOKE); float* tokw = (float*)(ws + WS_TOKW); unsigned* lrank = (unsigned*)(ws + WS_LRANK); int* blkcnt = (int*)(ws + WS_BLKCNT);
#pragma unroll
    for (int m = 0; m < 4; ++m) { const int k = F.tid + 512 * m; const float g = gn[k]; const f32x4 a = *(const GAS f32x4*)(rw + k * 8), b = *(const GAS f32x4*)(rw + k * 8 + 4);
        LAS float* p = RWL + (((k >> 9) * 8 + (k & 7)) * 64 + ((k >> 3) & 63)) * 8; *(LAS f32x4*)p = a * g; *(LAS f32x4*)(p + 4) = b * g; }
    __syncthreads();
    for (int blk = blockIdx.x; blk < T / 64; blk += F.G) {
        v4u nv[4];
        { const GAS v4u* xr = (const GAS v4u*)(xa + ((size_t)blk * 64 + 8 * w) * D) + lane;
#pragma unroll
          for (int j = 0; j < 4; ++j) nv[j] = xr[64 * j]; }
#pragma unroll 1
        for (int i = 0; i < 8; ++i) { const int tl = 8 * w + i; const size_t t = (size_t)blk * 64 + tl;
            v4u v[4];
#pragma unroll
            for (int j = 0; j < 4; ++j) v[j] = nv[j];
            { const GAS v4u* xr = (const GAS v4u*)(xa + (t + (i < 7 ? 1 : 0)) * D) + lane;
#pragma unroll
              for (int j = 0; j < 4; ++j) nv[j] = xr[64 * j]; }
            float acc[8], q = 0.f, mx = 0.f;
#pragma unroll
            for (int e = 0; e < 8; ++e) acc[e] = 0.f;
#pragma unroll
            for (int j = 0; j < 4; ++j) { const unsigned ww[4] = {v[j].x, v[j].y, v[j].z, v[j].w};
#pragma unroll
                for (int i8 = 0; i8 < 8; ++i8) { const float x = (i8 & 1) ? bfhi(ww[i8 >> 1]) : bflo(ww[i8 >> 1]);
                    const LAS float* p = RWL + ((j * 8 + i8) * 64 + lane) * 8; const f32x4 r0 = *(const LAS f32x4*)p, r1 = *(const LAS f32x4*)(p + 4);
                    acc[0] += x * r0.x; acc[1] += x * r0.y; acc[2] += x * r0.z; acc[3] += x * r0.w; acc[4] += x * r1.x; acc[5] += x * r1.y; acc[6] += x * r1.z; acc[7] += x * r1.w;
                    q += x * x; mx = fmaxf(mx, fabsf(x)); } }
#pragma unroll
            for (int e = 0; e < 8; ++e) acc[e] = wave_sum63(acc[e]);
            q = wave_sum63(q); mx = wave_max63(mx);
            if (lane == 63) { mx = fmaxf(mx, 1e-30f);
                const float rs = rsqrtf(q * (1.f / D) + EPS);
                int e1 = 0; float l1 = acc[0];
#pragma unroll
                for (int e = 1; e < 8; ++e) if (acc[e] > l1) { l1 = acc[e]; e1 = e; }
                int e2 = -1; float l2 = -__builtin_inff();
#pragma unroll
                for (int e = 0; e < 8; ++e) if (e != e1 && acc[e] > l2) { l2 = acc[e]; e2 = e; }
                const float w1 = 1.f / (1.f + expf((l2 - l1) * rs)), w2 = 1.f - w1;
                as_o[t] = mx * (1.f / 127.f) * rs; toke[t] = (unsigned)e1 | ((unsigned)e2 << 8); tokw[2 * t] = w1; tokw[2 * t + 1] = w2; eblk[tl] = (unsigned)e1 | ((unsigned)e2 << 8); invs[tl] = 127.f / mx; }
            LDS_WAIT();
            const float inv = invs[tl];
            GAS v2u* o8 = (GAS v2u*)(xq + t * D) + lane;
#pragma unroll
            for (int j = 0; j < 4; ++j) { const unsigned ww[4] = {v[j].x, v[j].y, v[j].z, v[j].w}; unsigned o[2];
#pragma unroll
                for (int h2 = 0; h2 < 2; ++h2) {
                    const unsigned q0 = __float_as_uint(__builtin_fmaf(bflo(ww[2 * h2]), inv, 12582912.f)), q1 = __float_as_uint(__builtin_fmaf(bfhi(ww[2 * h2]), inv, 12582912.f)), q2 = __float_as_uint(__builtin_fmaf(bflo(ww[2 * h2 + 1]), inv, 12582912.f)), q3 = __float_as_uint(__builtin_fmaf(bfhi(ww[2 * h2 + 1]), inv, 12582912.f));
                    o[h2] = __builtin_amdgcn_perm(__builtin_amdgcn_perm(q3, q2, 0x0c0c0400u), __builtin_amdgcn_perm(q1, q0, 0x0c0c0400u), 0x05040100u); }
                o8[64 * j] = (v2u){o[0], o[1]}; }
        }
        __syncthreads();
        if (F.wave == 0) { const unsigned ev = eblk[lane]; const int e1 = ev & 255u, e2 = ev >> 8; const unsigned long long lower = (1ull << lane) - 1ull; unsigned r0 = 0, r1 = 0; int mycnt = 0;
#pragma unroll
            for (int e = 0; e < 8; ++e) { const unsigned long long m = __ballot(e1 == e) | __ballot(e2 == e); const int cnt = __popcll(m);
                if (e1 == e) r0 = (unsigned)__popcll(m & lower); if (e2 == e) r1 = (unsigned)__popcll(m & lower); if (lane == e) mycnt = cnt; }
            if (lane < 8) blkcnt[blk * 8 + lane] = mycnt;
            lrank[(size_t)blk * 64 + lane] = r0 | (r1 << 16); }
        __syncthreads();
    }
}
__device__ __forceinline__ void gather_phase(const Args& A, const Frame& F) {
    unsigned char* ws = A.ws;
    const float* as_i = (const float*)(ws + WS_AS); const unsigned* toke = (const unsigned*)(ws + WS_TOKE); const float* tokw = (const float*)(ws + WS_TOKW); const unsigned* lrank = (const unsigned*)(ws + WS_LRANK);
    const int* blkcnt = (const int*)(ws + WS_BLKCNT); int* seg = (int*)(ws + WS_SEG); int* pos_o = (int*)(ws + WS_POS); float* ass = (float*)(ws + WS_ASS); float* gws = (float*)(ws + WS_GWS);
    const signed char* xq = (const signed char*)(ws + WS_XQ8); signed char* xp = (signed char*)(ws + WS_XP);
    LAS int* sh = (LAS int*)F.lds;
    const int lane = F.lane;
    for (int blk = blockIdx.x; blk < T / 64; blk += F.G) {
        { const int e = F.wave; int tot = 0, pre = 0;
#pragma unroll
          for (int j = 0; j < 4; ++j) { const int idx = lane + 64 * j; const int c = blkcnt[idx * 8 + e]; tot += c; pre += (idx < blk) ? c : 0; }
          tot = wave_sum_i(tot); pre = wave_sum_i(pre);
          if (lane == 0) { sh[e] = tot; sh[8 + e] = pre; } }
        __syncthreads();
        if (F.tid == 0) { int s = 0;
            for (int e = 0; e < 8; ++e) { sh[16 + e] = s; s += (sh[e] + 255) & ~255; }
            sh[24] = s;
            if (blk == 0) { for (int e = 0; e < 9; ++e) seg[e] = sh[16 + e]; } }
        __syncthreads();
        { const size_t tb = (size_t)blk * 64 + 8 * F.wave; const size_t tk = tb + (lane & 7);
          const unsigned evv = toke[tk], lrv = lrank[tk]; const float asv = as_i[tk], tw0 = tokw[2 * tk], tw1 = tokw[2 * tk + 1];
          v4u nr[2]; { const GAS v4u* src = (const GAS v4u*)(xq + tb * D) + lane; nr[0] = src[0]; nr[1] = src[64]; }
#pragma unroll 1
          for (int i = 0; i < 8; ++i) { const size_t t = tb + i; const v4u r0 = nr[0], r1 = nr[1];
              { const GAS v4u* src = (const GAS v4u*)(xq + (t + (i < 7 ? 1 : 0)) * D) + lane; nr[0] = src[0]; nr[1] = src[64]; }
              const unsigned ev = (unsigned)__builtin_amdgcn_readlane((int)evv, i), lr = (unsigned)__builtin_amdgcn_readlane((int)lrv, i);
              const int e0 = (int)(ev & 255u), e1 = (int)(ev >> 8);
              const int pos0 = sh[16 + e0] + sh[8 + e0] + (int)(lr & 0xffffu), pos1 = sh[16 + e1] + sh[8 + e1] + (int)(lr >> 16);
              if (lane == 0) { const float a_ = __builtin_bit_cast(float, __builtin_amdgcn_readlane(__builtin_bit_cast(int, asv), i));
                  pos_o[2 * t] = pos0; pos_o[2 * t + 1] = pos1; ass[pos0] = a_; ass[pos1] = a_;
                  gws[pos0] = __builtin_bit_cast(float, __builtin_amdgcn_readlane(__builtin_bit_cast(int, tw0), i)); gws[pos1] = __builtin_bit_cast(float, __builtin_amdgcn_readlane(__builtin_bit_cast(int, tw1), i)); }
              GAS v4u* d0 = (GAS v4u*)(xp + (size_t)pos0 * D) + lane; GAS v4u* d1 = (GAS v4u*)(xp + (size_t)pos1 * D) + lane;
              d0[0] = r0; d0[64] = r1; d1[0] = r0; d1[64] = r1; } }
        __syncthreads();
    }
}
__device__ __forceinline__ void final_phase(const Args& A, const Frame& F, const bf16* xa, float* out) {
    const int gw = blockIdx.x * NWAVES + F.wave, NGW = F.G * NWAVES, lane = F.lane;
    const int* pos = (const int*)(A.ws + WS_POS); const bf16* Y = (const bf16*)(A.ws + WS_Y); const float* gf = A.in[22];
    int2 pp = make_int2(0, 0); { const int tk = gw + lane * NGW; if (tk < T) pp = *(const int2*)(pos + 2 * tk); }
    v2u nx[8], na[8], nb[8];
#define FIN_LOAD(k_, t_) do { const int p0_ = __builtin_amdgcn_readlane(pp.x, (k_)), p1_ = __builtin_amdgcn_readlane(pp.y, (k_)); \
        const GAS v2u* xr_ = (const GAS v2u*)(xa + (size_t)(t_) * D) + lane; const GAS v2u* y0_ = (const GAS v2u*)(Y + (size_t)p0_ * D) + lane; const GAS v2u* y1_ = (const GAS v2u*)(Y + (size_t)p1_ * D) + lane; \
        _Pragma("unroll") for (int j = 0; j < 8; ++j) { nx[j] = xr_[64 * j]; na[j] = y0_[64 * j]; nb[j] = y1_[64 * j]; } } while (0)
    f32x4 gv[8];
#pragma unroll
    for (int j = 0; j < 8; ++j) gv[j] = *((const GAS f32x4*)gf + lane + 64 * j);
    if (gw < T) FIN_LOAD(0, gw);
#pragma unroll 1
    for (int k = 0, t = gw; t < T; ++k, t += NGW) {
        GAS f32x4* orow = (GAS f32x4*)(out + (size_t)t * D) + lane;
        f32x4 v[8]; float q = 0.f;
#pragma unroll
        for (int j = 0; j < 8; ++j) { const v2u x = nx[j], a = na[j], b = nb[j];
            v[j].x = bflo(x.x) + bflo(a.x) + bflo(b.x); v[j].y = bfhi(x.x) + bfhi(a.x) + bfhi(b.x); v[j].z = bflo(x.y) + bflo(a.y) + bflo(b.y); v[j].w = bfhi(x.y) + bfhi(a.y) + bfhi(b.y);
            q += (v[j].x * v[j].x + v[j].y * v[j].y) + (v[j].z * v[j].z + v[j].w * v[j].w); }
        if (t + NGW < T) FIN_LOAD(k + 1, t + NGW);
        q = wave_sum(q); const float rs = rsqrtf(q * (1.f / D) + EPS);
#pragma unroll
        for (int j = 0; j < 8; ++j) orow[64 * j] = v[j] * rs * gv[j];
    }
#undef FIN_LOAD
}

#ifndef REP_P0
#define REP_P0 1
#endif
#ifndef REP_T
#define REP_T 1
#endif
#ifndef REP_G
#define REP_G 1
#endif
__global__ void __launch_bounds__(NWAVES * 64, 2) hy_fwd(Args args) {
    extern __shared__ __attribute__((aligned(16))) unsigned char lds[];
    Frame F;
    F.lds = (LAS unsigned char*)lds;
    F.tid = threadIdx.x; F.lane = F.tid & 63; F.wave = __builtin_amdgcn_readfirstlane(F.tid >> 6); F.G = gridDim.x;
#define FRESH() do { int t_ = threadIdx.x; asm volatile("" : "+v"(t_)); F.tid = t_; F.lane = t_ & 63; F.wave = __builtin_amdgcn_readfirstlane(t_ >> 6); } while (0)
    unsigned char* ws = args.ws;
    for (int u = F.tid; u < (LDS_BYTES - LDSCTL_OFF) / 4; u += NWAVES * 64) ((LAS unsigned*)(F.lds + LDSCTL_OFF))[u] = 0u;
    __syncthreads();
    XcdBarrier bar; bar.bar = (unsigned*)(ws + WS_CTL) + CW_BAR; bar.x = 0; bar.st = nullptr;
#if !MK_PER_PHASE
    bar = xcd_barrier_post((unsigned*)(ws + WS_CTL) + CW_BAR, (volatile LAS unsigned*)(F.lds + MISC_OFF) + 8);
#endif
    const int lo = args.ph_lo, hi = args.ph_hi;
#define IN(k) (lo <= (k) && (k) < hi)
#if MK_PER_PHASE
#define SEAM(k) do { } while (0)
#else
#define SEAM(k) do { if (IN(k) && IN((k) + 1)) xcd_barrier(bar); } while (0)
#endif
    bf16* const PROJ = (bf16*)(ws + WS_PROJ); bf16* const AMIXB = (bf16*)(ws + WS_AMIXB); signed char* const AMIX8 = (signed char*)(ws + WS_AMIX8);
    float* const SSQA = (float*)(ws + WS_SSQA); float2* const LSUM = (float2*)(ws + WS_LSUM);
    const unsigned* const CM = (const unsigned*)(ws + WS_CMAX);
    bf16* const XA = (bf16*)(ws + WS_XA);
    bf16* const XB = (bf16*)(ws + WS_XB);

    if (IN(0)) { FRESH(); for (int rep = 0; rep < REP_P0; ++rep) p0_prologue(args, F); }
#if !MK_PER_PHASE
    xcd_census(bar);
#endif
    SEAM(0);

#pragma unroll 1
    for (int l = 0; l < 2; ++l) {
        const int pb = 1 + 9 * l;
        if (IN(pb)) {
            pg8::Gemm g{(const bf16*)(ws + WS_XQ8), (const bf16*)(ws + WS_WIN + (size_t)l * DIN * D), T, DIN, D / 2}; pg8::GroupOrder S; S.init(T / 256, DIN, F.G, (int)blockIdx.x);
            pg8::EpiScaleBf16I8P E{PROJ, DIN, (const float*)(ws + WS_AS), CM + CM_IN + l * DIN, 0};
            for (int rep = 0; rep < REP_G; ++rep) pg8::gemm_phase<pg8::EpiScaleBf16I8P, pg8::GroupOrder, PG8_ALIGN, PG8_SP2>(F.lds, g, S, E);
            if (l == 0) { FRESH(); wout_quant(args, F); }
        } SEAM(pb);
        if (IN(pb + 1)) { FRESH();
            for (int rep = 0; rep < REP_T; ++rep) {
            for (int u = blockIdx.x; u < 256; u += F.G) attn_unit(F, u, PROJ, AMIXB, SSQA, args.in[3] + l * 16);
            __syncthreads(); }
        } SEAM(pb + 1);
        if (IN(pb + 2)) { FRESH();
            for (int rep = 0; rep < REP_T; ++rep) for (int u = blockIdx.x; u < 256; u += F.G) mix_unit(args, F, u, l, PROJ, AMIXB, AMIX8, (float*)(ws + WS_ASM), SSQA, LSUM);
        } SEAM(pb + 2);
        if (IN(pb + 3)) {
            pg8::Gemm g{(const bf16*)AMIX8, (const bf16*)(ws + WS_WOUT + (size_t)l * D * D), T, D, D / 2}; pg8::GroupOrder S; S.init(T / 256, D, F.G, (int)blockIdx.x);
            pg8::EpiResidI8P E{XB, XA, (const float*)(ws + WS_ASM), CM + CM_OUT + l * D};
            for (int rep = 0; rep < REP_G; ++rep) pg8::gemm_phase<pg8::EpiResidI8P, pg8::GroupOrder, PG8_ALIGN, PG8_SP2>(F.lds, g, S, E);
        } SEAM(pb + 3);
        if (l == 0) {
            if (IN(5)) { FRESH(); for (int rep = 0; rep < REP_T; ++rep) rowquant16_phase(args, F, XA); } SEAM(5);
            if (IN(6)) {
                pg8::Gemm g{(const bf16*)(ws + WS_XQ8), (const bf16*)(ws + WS_WGU), T, 2 * DFF, D / 2}; pg8::GroupOrder S; S.init(T / 256, 2 * DFF, F.G, (int)blockIdx.x);
                pg8::EpiSwigluI8P E{(bf16*)(ws + WS_ACT), DFF, (const float*)(ws + WS_AS), CM + CM_GU, 0};
                for (int rep = 0; rep < REP_G; ++rep) pg8::gemm_phase<pg8::EpiSwigluI8P, pg8::GroupOrder, PG8_ALIGN, PG8_SP2>(F.lds, g, S, E);
            } SEAM(6);
            if (IN(7)) { FRESH(); for (int rep = 0; rep < REP_T; ++rep) actquant_phase<DFF, 8>(F, (const bf16*)(ws + WS_ACT), (signed char*)(ws + WS_ACT8), (float*)(ws + WS_ASD), nullptr, T); } SEAM(7);
            if (IN(8)) {
                pg8::Gemm g{(const bf16*)(ws + WS_ACT8), (const bf16*)(ws + WS_WD), T, D, DFF / 2}; pg8::GroupOrder S; S.init(T / 256, D, F.G, (int)blockIdx.x);
                pg8::EpiResidI8P E{XA, XB, (const float*)(ws + WS_ASD), CM + CM_D};
                for (int rep = 0; rep < REP_G; ++rep) pg8::gemm_phase<pg8::EpiResidI8P, pg8::GroupOrder, PG8_ALIGN, PG8_SP2>(F.lds, g, S, E);
            } SEAM(8);
            if (IN(9)) { FRESH(); for (int rep = 0; rep < REP_T; ++rep) rowquant16_phase(args, F, XB); } SEAM(9);
        } else {
            if (IN(14)) { FRESH(); for (int rep = 0; rep < REP_T; ++rep) router_phase(args, F, XA); } SEAM(14);
            if (IN(15)) { FRESH(); for (int rep = 0; rep < REP_T; ++rep) gather_phase(args, F); } SEAM(15);
            if (IN(16)) {
                const int* seg = (const int*)(ws + WS_SEG);
                pg8::GroupOrder S; S.init(seg[8] >> 8, 2 * DE, F.G, (int)blockIdx.x); S.estride = (size_t)2 * DE * D;
#pragma unroll
                for (int e = 0; e < 9; ++e) S.pstart[e] = seg[e] >> 8;
                pg8::Gemm g{(const bf16*)(ws + WS_XP), (const bf16*)(ws + WS_EGU), MROWS, 2 * DE, D / 2};
                pg8::EpiSwigluI8P E{(bf16*)(ws + WS_ACTM), DE, (const float*)(ws + WS_ASS), CM + CM_EGU, 2 * DE};
                for (int rep = 0; rep < REP_G; ++rep) pg8::gemm_phase<pg8::EpiSwigluI8P, pg8::GroupOrder, PG8_ALIGN, PG8_SP2>(F.lds, g, S, E);
            } SEAM(16);
            if (IN(17)) { FRESH(); const int nrows = ((const int*)(ws + WS_SEG))[8];
                for (int rep = 0; rep < REP_T; ++rep) actquant_phase<DE, 4>(F, (const bf16*)(ws + WS_ACTM), (signed char*)(ws + WS_ACTM8), (float*)(ws + WS_ASDM), (const float*)(ws + WS_GWS), nrows); } SEAM(17);
            if (IN(18)) {
                const int* seg = (const int*)(ws + WS_SEG);
                pg8::GroupOrder S; S.init(seg[8] >> 8, D, F.G, (int)blockIdx.x); S.estride = (size_t)D * DE;
#pragma unroll
                for (int e = 0; e < 9; ++e) S.pstart[e] = seg[e] >> 8;
                pg8::Gemm g{(const bf16*)(ws + WS_ACTM8), (const bf16*)(ws + WS_ED), MROWS, D, DE / 2};
                pg8::EpiScaleBf16I8P E{(bf16*)(ws + WS_Y), D, (const float*)(ws + WS_ASDM), CM + CM_ED, D};
                for (int rep = 0; rep < REP_G; ++rep) pg8::gemm_phase<pg8::EpiScaleBf16I8P, pg8::GroupOrder, PG8_ALIGN, PG8_SP2>(F.lds, g, S, E);
            } SEAM(18);
            if (IN(19)) { FRESH(); final_phase(args, F, XA, args.out); }
        }
    }
#undef IN
#undef SEAM
}

extern "C" void kernel_launch(void* const* d_in, const int* in_sizes, int n_in, void* d_out, int out_size, void* d_ws, size_t ws_size, hipStream_t stream) {
    static int grid = 0;
    if (grid == 0) {
        if (n_in != 23 || in_sizes[0] != T * D || out_size != T * D || ws_size < WS_END) { fprintf(stderr, "kernel_launch: unexpected shapes / workspace (%d inputs, ws %zu, need %zu)\n", n_in, ws_size, (size_t)WS_END); grid = -1; return; }
        int dev = 0, cus = 0;
        if (hipGetDevice(&dev) != hipSuccess || hipDeviceGetAttribute(&cus, hipDeviceAttributeMultiprocessorCount, dev) != hipSuccess) { grid = -1; return; }
        if (hipFuncSetAttribute((const void*)hy_fwd, hipFuncAttributeMaxDynamicSharedMemorySize, LDS_BYTES) != hipSuccess) { fprintf(stderr, "kernel_launch: hipFuncSetAttribute failed\n"); grid = -1; return; }
        int per_cu = 0;
        if (hipOccupancyMaxActiveBlocksPerMultiprocessor(&per_cu, (const void*)hy_fwd, NWAVES * 64, LDS_BYTES) != hipSuccess || per_cu < 1) fprintf(stderr, "kernel_launch: occupancy query reports %d\n", per_cu);
        (void)hipGetLastError();
        grid = cus;
    }
    if (grid < 0) return;
    if (hipMemsetAsync((char*)d_ws + WS_CTL, 0, CTL_ZERO_BYTES, stream) != hipSuccess) return;
    Args a{};
    for (int i = 0; i < 23; ++i) a.in[i] = (const float*)d_in[i];
    a.out = (float*)d_out; a.ws = (unsigned char*)d_ws;
#if MK_PER_PHASE
    for (int ph = 0; ph < N_PHASES; ++ph) { a.ph_lo = ph; a.ph_hi = ph + 1; hipLaunchKernelGGL(hy_fwd, dim3(grid), dim3(NWAVES * 64), LDS_BYTES, stream, a); }
#else
    a.ph_lo = 0; a.ph_hi = N_PHASES; hipLaunchKernelGGL(hy_fwd, dim3(grid), dim3(NWAVES * 64), LDS_BYTES, stream, a);
#endif
}
```
